# Optimizing an MI355X kernel written in HIP

```python
import math
import jax, jax.numpy as jnp
from jax import lax
import numpy as np

D_MODEL = 1024
BATCH = 4
SEQ = 8192
DEPTH = 2

CONV_WIDTH = D_MODEL // 4
CONV_KSIZE = 31
ML_HEADS = 4
ML_HEAD_DIM = D_MODEL // 16
ML_WIDTH = ML_HEADS * ML_HEAD_DIM
ML_QK_CONV = 4
ML_CHUNK = 128
DA_HEADS = 4
DA_QK_DIM = D_MODEL // 16
DA_V_DIM = 2 * DA_QK_DIM
DA_WIDTH = DA_HEADS * DA_V_DIM
Q_BLOCK = 128
D_FF = 4 * D_MODEL
SPLIT_SIZES = (CONV_WIDTH, CONV_WIDTH,
               2 * ML_WIDTH, ML_WIDTH, ML_WIDTH,
               ML_HEADS, ML_HEADS,
               DA_HEADS * 2 * DA_QK_DIM, DA_HEADS * 2 * DA_QK_DIM, DA_WIDTH)
SPLIT_POINTS = tuple(int(p) for p in np.cumsum(SPLIT_SIZES)[:-1])
D_IN_PROJ = sum(SPLIT_SIZES)
DEEPNORM_ALPHA = (2 * DEPTH) ** 0.25
DEEPNORM_BETA = (8 * DEPTH) ** -0.25
LN_EPS = 1e-5

kernel_name = 'hymba_conv_mlstm_diffattn_deepnorm'


def layer_norm(x, g, b=None):
    xf = x.astype(jnp.float32)
    mu = jnp.mean(xf, axis=-1, keepdims=True)
    var = jnp.mean(jnp.square(xf - mu), axis=-1, keepdims=True)
    y = ((xf - mu) * lax.rsqrt(var + LN_EPS)).astype(x.dtype) * g
    return y if b is None else y + b


def rms_norm(x, g):
    xf = x.astype(jnp.float32)
    y = xf * lax.rsqrt(jnp.mean(jnp.square(xf), axis=-1, keepdims=True) + LN_EPS)
    return y.astype(x.dtype) * g


def causal_depthwise_conv(x, w, b):
    ksize, ch = w.shape
    y = lax.conv_general_dilated(x, w[:, None, :].astype(x.dtype), window_strides=(1,),
                                 padding=((ksize - 1, 0),),
                                 dimension_numbers=('NWC', 'WIO', 'NWC'),
                                 feature_group_count=ch)
    return y + b


def mlstm_chunkwise(q, k, v, log_i, log_f):
    bsz, nh, s, dh = q.shape
    nc = s // ML_CHUNK
    f32 = jnp.float32
    q = q.astype(f32).reshape(bsz, nh, nc, ML_CHUNK, dh)
    k = (k.astype(f32) * dh ** -0.5).reshape(bsz, nh, nc, ML_CHUNK, dh)
    v = v.astype(f32).reshape(bsz, nh, nc, ML_CHUNK, dh)
    log_i = log_i.astype(f32).reshape(bsz, nh, nc, ML_CHUNK)
    log_f = log_f.astype(f32).reshape(bsz, nh, nc, ML_CHUNK)
    b = jnp.cumsum(log_f, axis=-1)
    g = b[..., -1]
    w_end = g[..., None] - b + log_i
    m_loc = jnp.max(w_end, axis=-1)
    p_end = jnp.exp(w_end - m_loc[..., None])
    c_loc = jnp.einsum('bhcsv,bhcsk->bhcvk', p_end[..., None] * v, k)
    n_loc = jnp.einsum('bhcs,bhcsk->bhck', p_end, k)

    def step(carry, xs):
        c, n, m = carry
        g_c, m_c, c_c, n_c = xs
        m_new = jnp.maximum(g_c + m, m_c)
        a = jnp.exp(g_c + m - m_new)
        e = jnp.exp(m_c - m_new)
        c_new = a[..., None, None] * c + e[..., None, None] * c_c
        n_new = a[..., None] * n + e[..., None] * n_c
        return (c_new, n_new, m_new), (c, n, m)

    init = (jnp.zeros((bsz, nh, dh, dh), f32), jnp.zeros((bsz, nh, dh), f32),
            jnp.zeros((bsz, nh), f32))
    xs = (jnp.moveaxis(g, 2, 0), jnp.moveaxis(m_loc, 2, 0),
          jnp.moveaxis(c_loc, 2, 0), jnp.moveaxis(n_loc, 2, 0))
    _, (c_prev, n_prev, m_prev) = lax.scan(step, init, xs)
    c_prev = jnp.moveaxis(c_prev, 0, 2)
    n_prev = jnp.moveaxis(n_prev, 0, 2)
    m_prev = jnp.moveaxis(m_prev, 0, 2)

    causal = jnp.tril(jnp.ones((ML_CHUNK, ML_CHUNK), dtype=bool))
    d = jnp.where(causal, b[..., :, None] - b[..., None, :] + log_i[..., None, :], -jnp.inf)
    inter = b + m_prev[..., None]
    m_pos = jnp.maximum(inter, jnp.max(d, axis=-1))
    a_inter = jnp.exp(inter - m_pos)
    sc = jnp.einsum('bhcjd,bhcsd->bhcjs', q, k) * jnp.exp(d - m_pos[..., None])
    num = (a_inter[..., None] * jnp.einsum('bhcvk,bhcjk->bhcjv', c_prev, q)
           + jnp.einsum('bhcjs,bhcsv->bhcjv', sc, v))
    den = a_inter * jnp.einsum('bhck,bhcjk->bhcj', n_prev, q) + jnp.sum(sc, axis=-1)
    h = num / jnp.maximum(jnp.abs(den), jnp.exp(-m_pos))[..., None]
    return h.reshape(bsz, nh, s, dh)


def diff_attention(q, k, v, lam, norm_g):
    bsz, s, nh, _, dk = q.shape
    dv = v.shape[-1]
    nqb = s // Q_BLOCK
    scale = dk ** -0.5
    kh = k.transpose(0, 2, 3, 1, 4)
    vh = v.transpose(0, 2, 1, 3)
    qb = q.transpose(0, 2, 3, 1, 4).reshape(bsz, nh, 2, nqb, Q_BLOCK, dk).transpose(3, 0, 1, 2, 4, 5)
    kpos = jnp.arange(s)

    def block(args):
        q_blk, i = args
        sc = jnp.einsum('bhmqd,bhmkd->bhmqk', q_blk, kh).astype(jnp.float32) * scale
        qpos = i * Q_BLOCK + jnp.arange(Q_BLOCK)
        sc = jnp.where(kpos[None, :] <= qpos[:, None], sc, -jnp.inf)
        p = jax.nn.softmax(sc, axis=-1)
        w = p[:, :, 0] - lam * p[:, :, 1]
        return jnp.einsum('bhqk,bhkv->bhqv', w.astype(vh.dtype), vh)

    o = lax.map(block, (qb, jnp.arange(nqb)))
    o = o.transpose(1, 0, 3, 2, 4).reshape(bsz, s, nh, dv)
    return rms_norm(o, norm_g)


def hybrid_mixer(x, w_in, b_igate, b_fgate, conv_dw_w, conv_dw_b, conv_ln_g, conv_ln_b,
                 conv_pw_w, conv_pw_b, ml_conv_w, ml_conv_b, ml_norm_g,
                 lam_q1, lam_k1, lam_q2, lam_k2, da_norm_g, w_out, lambda_init):
    bsz, s, _ = x.shape
    u = x @ w_in
    (c_a, c_g, m_qk, m_v, m_o, m_i, m_f, d_q, d_k, d_v) = jnp.split(u, SPLIT_POINTS, axis=-1)

    y = c_a * jax.nn.sigmoid(c_g)
    y = causal_depthwise_conv(y, conv_dw_w, conv_dw_b)
    y = jax.nn.silu(layer_norm(y, conv_ln_g, conv_ln_b))
    y_conv = y @ conv_pw_w + conv_pw_b

    qk = jax.nn.silu(causal_depthwise_conv(m_qk, ml_conv_w, ml_conv_b))
    q_m, k_m = jnp.split(qk, 2, axis=-1)
    to_heads = lambda t: t.reshape(bsz, s, ML_HEADS, ML_HEAD_DIM).transpose(0, 2, 1, 3)
    log_i = (m_i + b_igate).astype(jnp.float32).transpose(0, 2, 1)
    log_f = jax.nn.log_sigmoid((m_f + b_fgate).astype(jnp.float32)).transpose(0, 2, 1)
    h = mlstm_chunkwise(to_heads(q_m), to_heads(k_m), to_heads(m_v), log_i, log_f)
    h = h.transpose(0, 2, 1, 3).astype(x.dtype) * jax.nn.sigmoid(m_o).reshape(bsz, s, ML_HEADS, ML_HEAD_DIM)
    y_ml = layer_norm(h, ml_norm_g.reshape(ML_HEADS, ML_HEAD_DIM)).reshape(bsz, s, ML_WIDTH)

    lam = (jnp.exp(jnp.sum(lam_q1.astype(jnp.float32) * lam_k1.astype(jnp.float32)))
           - jnp.exp(jnp.sum(lam_q2.astype(jnp.float32) * lam_k2.astype(jnp.float32)))
           + lambda_init)
    y_da = diff_attention(d_q.reshape(bsz, s, DA_HEADS, 2, DA_QK_DIM),
                          d_k.reshape(bsz, s, DA_HEADS, 2, DA_QK_DIM),
                          d_v.reshape(bsz, s, DA_HEADS, DA_V_DIM), lam, da_norm_g)
    y_da = (y_da * (1.0 - lambda_init)).reshape(bsz, s, DA_WIDTH)

    return jnp.concatenate([y_conv, y_ml, y_da], axis=-1) @ w_out


def setup_inputs(seed: int = 0) -> dict:
    key = jax.random.key(seed)
    ks = jax.random.split(key, 26)
    L = DEPTH
    nrm = lambda k, shape, scale: jax.random.normal(k, shape, jnp.float32) * scale
    x = nrm(ks[0], (BATCH, SEQ, D_MODEL), 1.0)
    w_in = nrm(ks[1], (L, D_MODEL, D_IN_PROJ), D_MODEL ** -0.5)
    b_igate = nrm(ks[2], (L, ML_HEADS), 0.1)
    b_fgate = (jnp.broadcast_to(jnp.linspace(3.0, 6.0, ML_HEADS, dtype=jnp.float32), (L, ML_HEADS))
               + nrm(ks[3], (L, ML_HEADS), 0.01))
    conv_dw_w = nrm(ks[4], (L, CONV_KSIZE, CONV_WIDTH), CONV_KSIZE ** -0.5)
    conv_dw_b = nrm(ks[5], (L, CONV_WIDTH), 0.01)
    conv_ln_g = 1.0 + nrm(ks[6], (L, CONV_WIDTH), 0.01)
    conv_ln_b = nrm(ks[7], (L, CONV_WIDTH), 0.01)
    conv_pw_w = nrm(ks[8], (L, CONV_WIDTH, CONV_WIDTH), CONV_WIDTH ** -0.5 * DEEPNORM_BETA)
    conv_pw_b = nrm(ks[9], (L, CONV_WIDTH), 0.01)
    ml_conv_w = nrm(ks[10], (L, ML_QK_CONV, 2 * ML_WIDTH), ML_QK_CONV ** -0.5)
    ml_conv_b = nrm(ks[11], (L, 2 * ML_WIDTH), 0.01)
    ml_norm_g = 1.0 + nrm(ks[12], (L, ML_WIDTH), 0.01)
    lam_q1 = nrm(ks[13], (L, DA_QK_DIM), 0.1)
    lam_k1 = nrm(ks[14], (L, DA_QK_DIM), 0.1)
    lam_q2 = nrm(ks[15], (L, DA_QK_DIM), 0.1)
    lam_k2 = nrm(ks[16], (L, DA_QK_DIM), 0.1)
    da_norm_g = 1.0 + nrm(ks[17], (L, DA_V_DIM), 0.01)
    w_out = nrm(ks[18], (L, D_MODEL, D_MODEL), D_MODEL ** -0.5 * DEEPNORM_BETA)
    ln1_g = 1.0 + nrm(ks[19], (L, D_MODEL), 0.01)
    ln1_b = nrm(ks[20], (L, D_MODEL), 0.01)
    w_up = nrm(ks[21], (L, D_MODEL, D_FF), D_MODEL ** -0.5 * DEEPNORM_BETA)
    w_down = nrm(ks[22], (L, D_FF, D_MODEL), D_FF ** -0.5 * DEEPNORM_BETA)
    ln2_g = 1.0 + nrm(ks[23], (L, D_MODEL), 0.01)
    ln2_b = nrm(ks[24], (L, D_MODEL), 0.01)
    return {'x': x, 'w_in': w_in, 'b_igate': b_igate, 'b_fgate': b_fgate,
            'conv_dw_w': conv_dw_w, 'conv_dw_b': conv_dw_b, 'conv_ln_g': conv_ln_g,
            'conv_ln_b': conv_ln_b, 'conv_pw_w': conv_pw_w, 'conv_pw_b': conv_pw_b,
            'ml_conv_w': ml_conv_w, 'ml_conv_b': ml_conv_b, 'ml_norm_g': ml_norm_g,
            'lam_q1': lam_q1, 'lam_k1': lam_k1, 'lam_q2': lam_q2, 'lam_k2': lam_k2,
            'da_norm_g': da_norm_g, 'w_out': w_out, 'ln1_g': ln1_g, 'ln1_b': ln1_b,
            'w_up': w_up, 'w_down': w_down, 'ln2_g': ln2_g, 'ln2_b': ln2_b}


def reference(x, w_in, b_igate, b_fgate, conv_dw_w, conv_dw_b, conv_ln_g, conv_ln_b,
              conv_pw_w, conv_pw_b, ml_conv_w, ml_conv_b, ml_norm_g,
              lam_q1, lam_k1, lam_q2, lam_k2, da_norm_g, w_out, ln1_g, ln1_b,
              w_up, w_down, ln2_g, ln2_b):
    for l in range(DEPTH):
        lambda_init = 0.8 - 0.6 * math.exp(-0.3 * l)
        h = hybrid_mixer(x, w_in[l], b_igate[l], b_fgate[l], conv_dw_w[l], conv_dw_b[l],
                         conv_ln_g[l], conv_ln_b[l], conv_pw_w[l], conv_pw_b[l],
                         ml_conv_w[l], ml_conv_b[l], ml_norm_g[l],
                         lam_q1[l], lam_k1[l], lam_q2[l], lam_k2[l], da_norm_g[l],
                         w_out[l], lambda_init)
        x = layer_norm(DEEPNORM_ALPHA * x + h, ln1_g[l], ln1_b[l])
        h = jnp.square(jax.nn.relu(x @ w_up[l])) @ w_down[l]
        x = layer_norm(DEEPNORM_ALPHA * x + h, ln2_g[l], ln2_b[l])
    return x
```

```cpp
#include <hip/hip_runtime.h>
#include <hip/hip_cooperative_groups.h>
#include <cstdio>
#include <cstdint>
#include <cmath>
namespace cg = cooperative_groups;
namespace pg8 {
#define PG8_LAS __attribute__((address_space(3)))
typedef unsigned short bf16_t;
typedef short bf16x8 __attribute__((ext_vector_type(8)));
typedef float f32x4 __attribute__((ext_vector_type(4)));
typedef unsigned u32x4 __attribute__((ext_vector_type(4)));
constexpr int BM = 256, BK = 64, HALF = 128, HTB = HALF * BK * 2  , STAGE_BYTES = 8 * HTB, NXCD = 8, WGM = 8;

__host__ __device__ __forceinline__ int lds_byte(int r, int c) { const int st = (r >> 4) * 2 + (c >> 5), rr = r & 15, cc = c & 31, ob = rr * 64 + cc * 2; return st * 1024 + (ob ^ (((ob >> 9) & 1) << 5)); }
__host__ __device__ __forceinline__ void stage_rc(int b, int& R, int& C) { const int st = b / 1024, sb = b % 1024, swz = sb ^ (((sb >> 9) & 1) << 5); R = (st >> 1) * 16 + swz / 64; C = (st & 1) * 32 + (swz % 64) / 2; }
__host__ __device__ __forceinline__ int perm32(int rho) { const int n = rho >> 4, i = rho & 15; return 8 * (i >> 2) + 4 * n + (i & 3); }

struct Unit { int pm, pn; };
struct Gemm { const bf16_t* A; const bf16_t* Bt; int M, N, K; };

struct StaticOrder {
    int nM, nN, nwg, G, c;
    __host__ __device__ void init(int M, int N, int G_, int c_) { nM = M / BM; nN = N / BM; nwg = nM * nN; G = G_; c = c_; }
    __host__ __device__ bool next(int i, Unit& u) const {
        const long L = (long)i * G + c; if (L >= nwg) return false;
        int wgid = (int)L; { const int q = nwg / NXCD, r = nwg % NXCD, xcd = wgid % NXCD, off = wgid / NXCD; wgid = (xcd < r ? xcd * (q + 1) : r * (q + 1) + (xcd - r) * q) + off; }
        const int nig = WGM * nN, gid = wgid / nig, fm = gid * WGM, gsz = (nM - fm) < WGM ? (nM - fm) : WGM;
        u.pm = fm + ((wgid % nig) % gsz); u.pn = (wgid % nig) / gsz; return true;
    }
    __device__ __forceinline__ void a_ready(const Unit&) const {}
    __device__ __forceinline__ void done(const Unit&) const {}
};
__device__ __forceinline__ unsigned cvt_pk_bf16(float lo, float hi) { unsigned r; asm volatile("v_cvt_pk_bf16_f32 %0, %1, %2" : "=v"(r) : "v"(lo), "v"(hi)); return r; }
typedef float f32x2 __attribute__((ext_vector_type(2)));
template <int ACT  > struct EpiBf16 {
    static constexpr bool PERM = true, AFTER_DRAIN = false;
    bf16_t* O; int ldc;
    __device__ __forceinline__ void operator()(const f32x4 (&acc)[2][2][4][2], const Unit& u, int wr, int wc, int fr, int fq) const {
        const int row0 = u.pm * BM + wr * 64 + fr; const int col0 = u.pn * BM + wc * 32 + 8 * fq;
#pragma unroll
        for (int ai = 0; ai < 2; ++ai)
#pragma unroll
            for (int m = 0; m < 4; ++m) { bf16_t* rowp = O + (size_t)(row0 + ai * HALF + m * 16) * ldc + col0;
#pragma unroll
                for (int bj = 0; bj < 2; ++bj) { f32x4 v0 = acc[ai][bj][m][0], v1 = acc[ai][bj][m][1];
                    if (ACT == 2) {
#pragma unroll
                        for (int e = 0; e < 4; ++e) { const float a = fmaxf(v0[e], 0.f), b = fmaxf(v1[e], 0.f); v0[e] = a * a; v1[e] = b * b; } }
                    u32x4 w; w.x = cvt_pk_bf16(v0[0], v0[1]); w.y = cvt_pk_bf16(v0[2], v0[3]); w.z = cvt_pk_bf16(v1[0], v1[1]); w.w = cvt_pk_bf16(v1[2], v1[3]);
                    *(u32x4*)(rowp + bj * HALF) = w; } }
    }
};
struct EpiRes {
    static constexpr bool PERM = false, AFTER_DRAIN = false;
    const float* base; float* out; int ldc; float alpha;
    __device__ __forceinline__ void operator()(const f32x4 (&acc)[2][2][4][2], const Unit& u, int wr, int wc, int fr, int fq) const {
        const int col0 = u.pn * BM + wc * 32 + 4 * fq;
#pragma unroll
        for (int ai = 0; ai < 2; ++ai)
#pragma unroll
            for (int m = 0; m < 4; ++m) { const int r = u.pm * BM + ai * HALF + wr * 64 + m * 16 + fr; const size_t off = (size_t)r * ldc + col0;
#pragma unroll
                for (int bj = 0; bj < 2; ++bj)
#pragma unroll
                    for (int n = 0; n < 2; ++n) { const f32x4 bs = *(const f32x4*)(base + off + bj * HALF + n * 16); const f32x4 o = bs * alpha + acc[ai][bj][m][n];
                        *(f32x4*)(out + off + bj * HALF + n * 16) = o; }
                asm volatile("" ::: "memory"); }
    }
};
template <class Epi, class Sched, bool ALIGN_EPI = false, bool SP2 = false>
__device__ __forceinline__ void gemm_phase(PG8_LAS unsigned char* lds, const Gemm g, const Sched& S, const Epi& E) {
    const int tid = threadIdx.x, wid = __builtin_amdgcn_readfirstlane(tid >> 6), lane = tid & 63, wr = wid >> 2, wc = wid & 3, fr = lane & 15, fq = lane >> 4;
    const int K = g.K, nt = K / BK;
    unsigned voffA[2], voffB[2];
#pragma unroll
    for (int i = 0; i < 2; ++i) { int R, C; stage_rc(tid * 16 + i * 8192, R, C); const int Rb = Epi::PERM ? ((R & ~31) + perm32(R & 31)) : R;
        voffA[i] = (unsigned)(R * K + C) * 2u; voffB[i] = (unsigned)(Rb * K + C) * 2u; }
    const size_t kstep = (size_t)(BK * 2);
    const size_t hstep = (size_t)HALF * K * 2;
    const size_t tstep = 2 * hstep;
    const unsigned ldsw = (unsigned)wid * 1024u;
    const int aoff = lds_byte(wr * 64 + fr, fq * 8), boff = lds_byte(wc * 32 + fr, fq * 8);
#define PG8_SA(b, h) (((b) * 2 + (h)) * HTB)
#define PG8_SB(b, h) ((4 + (b) * 2 + (h)) * HTB)
#define PG8_STAGE(bufoff, gbase, voff) do { _Pragma("unroll") for (int _i = 0; _i < 2; ++_i) \
        __builtin_amdgcn_global_load_lds((const unsigned*)((const char*)(gbase) + (voff)[_i]), (PG8_LAS unsigned*)(lds + (bufoff) + ldsw + _i * 8192), 16, 0, 0); } while (0)
#define PG8_LDA(dst, b, h) do { _Pragma("unroll") for (int m = 0; m < 4; ++m) _Pragma("unroll") for (int k = 0; k < 2; ++k) dst[m][k] = *(const PG8_LAS bf16x8*)(lds + PG8_SA(b, h) + aoff + m * 2048 + k * 1024); } while (0)
#define PG8_LDB(dst, b, h) do { _Pragma("unroll") for (int n = 0; n < 2; ++n) _Pragma("unroll") for (int k = 0; k < 2; ++k) dst[n][k] = *(const PG8_LAS bf16x8*)(lds + PG8_SB(b, h) + boff + n * 2048 + k * 1024); } while (0)
#define PG8_MMA(ai, bj, At, Bt) do { __builtin_amdgcn_s_setprio(1); _Pragma("unroll") for (int m = 0; m < 4; ++m) _Pragma("unroll") for (int n = 0; n < 2; ++n) _Pragma("unroll") for (int k = 0; k < 2; ++k) \
        acc[ai][bj][m][n] = __builtin_amdgcn_mfma_f32_16x16x32_bf16(Bt[n][k], At[m][k], acc[ai][bj][m][n], 0, 0, 0); __builtin_amdgcn_s_setprio(0); } while (0)
#define PG8_WAIT_V(n) asm volatile("s_waitcnt vmcnt(" #n ")" ::: "memory")
#define PG8_WAIT_L(n) asm volatile("s_waitcnt lgkmcnt(" #n ")" ::: "memory")
#define PG8_BAR __builtin_amdgcn_s_barrier()
#define PG8_SCHED __builtin_amdgcn_sched_barrier(0)
    Unit cur, nxt; int ui = 0;
    if (!S.next(0, cur)) return;
    f32x4 acc[2][2][4][2];
#pragma unroll
    for (int a = 0; a < 2; ++a)
#pragma unroll
        for (int b = 0; b < 2; ++b)
#pragma unroll
            for (int m = 0; m < 4; ++m)
#pragma unroll
                for (int n = 0; n < 2; ++n) acc[a][b][m][n] = (f32x4){0.f, 0.f, 0.f, 0.f};
    bf16x8 At[4][2], B0[2][2], B1[2][2];
    const char* cA = (const char*)g.A + (size_t)cur.pm * tstep; const char* cB = (const char*)g.Bt + (size_t)cur.pn * tstep;
    S.a_ready(cur);
    if constexpr (SP2) {
        PG8_STAGE(PG8_SB(0, 0), cB, voffB); PG8_STAGE(PG8_SB(0, 1), cB + hstep, voffB); PG8_STAGE(PG8_SA(0, 0), cA, voffA); PG8_STAGE(PG8_SA(0, 1), cA + hstep, voffA);
        if (wr == 1) PG8_BAR;
        PG8_WAIT_V(2); PG8_BAR;
        PG8_STAGE(PG8_SB(1, 0), cB + kstep, voffB); PG8_STAGE(PG8_SA(1, 0), cA + kstep, voffA); PG8_STAGE(PG8_SB(1, 1), cB + hstep + kstep, voffB);
        PG8_WAIT_V(6); PG8_BAR;
    } else {
        PG8_STAGE(PG8_SB(0, 0), cB, voffB); PG8_STAGE(PG8_SA(0, 0), cA, voffA); PG8_STAGE(PG8_SB(0, 1), cB + hstep, voffB); PG8_STAGE(PG8_SA(0, 1), cA + hstep, voffA);
        if (wr == 1) PG8_BAR;
        PG8_WAIT_V(4); PG8_BAR;
        PG8_STAGE(PG8_SB(1, 0), cB + kstep, voffB); PG8_STAGE(PG8_SA(1, 0), cA + kstep, voffA); PG8_STAGE(PG8_SB(1, 1), cB + hstep + kstep, voffB);
        PG8_WAIT_V(6); PG8_BAR;
    }
    for (;;) {
        const bool has_next = S.next(ui + 1, nxt);
        const char* nA = has_next ? (const char*)g.A + (size_t)nxt.pm * tstep : cA; const char* nB = has_next ? (const char*)g.Bt + (size_t)nxt.pn * tstep : cB;
        for (int t = 0; t < nt; t += 2) {
            const bool last = (t == nt - 2);
            const char* a1 = cA + (size_t)(t + 1) * kstep;
            const char* a2 = last ? nA : cA + (size_t)(t + 2) * kstep; const char* b2 = last ? nB : cB + (size_t)(t + 2) * kstep;
            const char* a3 = a2 + kstep; const char* b3 = b2 + kstep;
            if (last && has_next) S.a_ready(nxt);
            if constexpr (SP2) {
            PG8_LDB(B0, 0, 0); PG8_LDB(B1, 0, 1); PG8_SCHED; PG8_LDA(At, 0, 0); PG8_STAGE(PG8_SA(1, 1), a1 + hstep, voffA);
            PG8_WAIT_V(8); PG8_WAIT_L(0); PG8_BAR; PG8_MMA(0, 0, At, B0); PG8_MMA(0, 1, At, B1); PG8_BAR; PG8_SCHED;
            PG8_LDA(At, 0, 1); PG8_STAGE(PG8_SB(0, 0), b2, voffB); PG8_STAGE(PG8_SB(0, 1), b2 + hstep, voffB); PG8_STAGE(PG8_SA(0, 0), a2, voffA);
            PG8_WAIT_V(8); PG8_WAIT_L(0); PG8_BAR; PG8_MMA(1, 0, At, B0); PG8_MMA(1, 1, At, B1); PG8_BAR; PG8_SCHED;
            PG8_LDB(B0, 1, 0); PG8_LDB(B1, 1, 1); PG8_SCHED; PG8_LDA(At, 1, 0); PG8_STAGE(PG8_SA(0, 1), a2 + hstep, voffA);
            PG8_WAIT_V(8); PG8_WAIT_L(0); PG8_BAR; PG8_MMA(0, 0, At, B0); PG8_MMA(0, 1, At, B1); PG8_BAR; PG8_SCHED;
            PG8_LDA(At, 1, 1); PG8_STAGE(PG8_SB(1, 0), b3, voffB); PG8_STAGE(PG8_SB(1, 1), b3 + hstep, voffB); PG8_STAGE(PG8_SA(1, 0), a3, voffA);
            PG8_WAIT_V(8); PG8_WAIT_L(0); PG8_BAR; PG8_MMA(1, 0, At, B0); PG8_MMA(1, 1, At, B1); PG8_BAR; PG8_SCHED;
            } else {
            PG8_LDB(B0, 0, 0); PG8_SCHED; PG8_LDA(At, 0, 0); PG8_STAGE(PG8_SA(1, 1), a1 + hstep, voffA);
            PG8_WAIT_L(8); PG8_BAR; PG8_WAIT_L(0); PG8_MMA(0, 0, At, B0); PG8_BAR; PG8_SCHED;
            PG8_LDB(B1, 0, 1); PG8_STAGE(PG8_SB(0, 0), b2, voffB);
            PG8_BAR; PG8_WAIT_L(0); PG8_MMA(0, 1, At, B1); PG8_BAR;
            PG8_LDA(At, 0, 1); PG8_STAGE(PG8_SA(0, 0), a2, voffA);
            PG8_BAR; PG8_WAIT_L(0); PG8_MMA(1, 0, At, B0); PG8_BAR; PG8_SCHED;
            PG8_STAGE(PG8_SB(0, 1), b2 + hstep, voffB);
            PG8_WAIT_V(6); PG8_BAR; PG8_MMA(1, 1, At, B1); PG8_BAR;
            PG8_LDB(B0, 1, 0); PG8_SCHED; PG8_LDA(At, 1, 0); PG8_STAGE(PG8_SA(0, 1), a2 + hstep, voffA);
            PG8_WAIT_L(8); PG8_BAR; PG8_WAIT_L(0); PG8_MMA(0, 0, At, B0); PG8_BAR; PG8_SCHED;
            PG8_LDB(B1, 1, 1); PG8_STAGE(PG8_SB(1, 0), b3, voffB);
            PG8_BAR; PG8_WAIT_L(0); PG8_MMA(0, 1, At, B1); PG8_BAR;
            PG8_LDA(At, 1, 1); PG8_STAGE(PG8_SA(1, 0), a3, voffA);
            PG8_BAR; PG8_WAIT_L(0); PG8_MMA(1, 0, At, B0); PG8_BAR; PG8_SCHED;
            PG8_STAGE(PG8_SB(1, 1), b3 + hstep, voffB);
            PG8_WAIT_V(6); PG8_BAR; PG8_MMA(1, 1, At, B1); PG8_BAR;
            }
        }
        if constexpr (ALIGN_EPI) { if (wr == 0) PG8_BAR; }
        if constexpr (!Epi::AFTER_DRAIN) { E(acc, cur, wr, wc, fr, fq); S.done(cur); }
        if (!has_next) break;
#pragma unroll
        for (int a = 0; a < 2; ++a)
#pragma unroll
            for (int b = 0; b < 2; ++b)
#pragma unroll
                for (int m = 0; m < 4; ++m)
#pragma unroll
                    for (int n = 0; n < 2; ++n) acc[a][b][m][n] = (f32x4){0.f, 0.f, 0.f, 0.f};
        cur = nxt; cA = nA; cB = nB; ++ui;
        if constexpr (ALIGN_EPI) { if (wr == 1) PG8_BAR; }
    }
    PG8_WAIT_V(0);
    if constexpr (!ALIGN_EPI) { if (wr == 0) PG8_BAR; }
    PG8_BAR;
    if constexpr (Epi::AFTER_DRAIN) { E.fused(acc, cur, wr, wc, fr, fq, lds, wid, lane); S.done(cur); }
#undef PG8_SA
#undef PG8_SB
#undef PG8_STAGE
#undef PG8_LDA
#undef PG8_LDB
#undef PG8_MMA
#undef PG8_WAIT_V
#undef PG8_WAIT_L
#undef PG8_BAR
#undef PG8_SCHED
}
}

#define LAS __attribute__((address_space(3)))
typedef unsigned short bf16_t;
typedef short bf16x8 __attribute__((ext_vector_type(8)));
typedef short s16x4 __attribute__((ext_vector_type(4)));
typedef float f32x4 __attribute__((ext_vector_type(4)));
typedef float f32x16 __attribute__((ext_vector_type(16)));
typedef unsigned u32x4 __attribute__((ext_vector_type(4)));
typedef unsigned u32x2 __attribute__((ext_vector_type(2)));

constexpr int BATCH = 4, SEQ = 8192, DM = 1024, M = BATCH * SEQ, NU = 3072, DFF = 4096, NIN = 3080;
constexpr float LN_EPS = 1e-5f;
constexpr float ALPHA = 1.4142135623730951f;
constexpr int NTHREADS = 512, NWAVES = 8;
constexpr int LDS_BYTES = 147456;

constexpr size_t MiB = 1u << 20;
constexpr size_t WS_CTL = 0, CTL_BYTES = 4096;
constexpr size_t WS_WIN = 2 * MiB, WS_WOUT = 14 * MiB, WS_WUP = 18 * MiB, WS_WDN = 34 * MiB, WS_PW = 50 * MiB, WS_WG = 50 * MiB + 512 * 1024;
constexpr size_t WS_G = 51 * MiB, WS_XB = 52 * MiB, WS_CAT = 116 * MiB, WS_U = 180 * MiB, WS_END = 436 * MiB;

constexpr int UC_CA = 0, UC_CG = 256, UC_MQK = 512, UC_MV = 1024, UC_MO = 1280, UC_DQ = 1536, UC_DK = 2048, UC_DV = 2560;

struct Args { const float* in[25]; float* out; unsigned char* ws; };

__device__ __forceinline__ float wave_sum(float v) {
#pragma unroll
    for (int o = 1; o < 64; o <<= 1) v += __shfl_xor(v, o);
    return v;
}
__device__ __forceinline__ unsigned pk_bf16(float lo, float hi) { typedef float f2 __attribute__((ext_vector_type(2))); typedef __bf16 b2 __attribute__((ext_vector_type(2))); f2 v = {lo, hi}; b2 b = __builtin_convertvector(v, b2); return __builtin_bit_cast(unsigned, b); }
__device__ __forceinline__ float bf_lo(unsigned u) { return __uint_as_float(u << 16); }
__device__ __forceinline__ float bf_hi(unsigned u) { return __uint_as_float(u & 0xffff0000u); }
__device__ __forceinline__ float bf2f(bf16_t h) { return __uint_as_float(((unsigned)h) << 16); }
__device__ __forceinline__ bf16_t f2bf(float f) { return (bf16_t)(pk_bf16(f, 0.f) & 0xffffu); }
__device__ __forceinline__ float sigmoidf_(float x) { return 1.f / (1.f + __expf(-x)); }
#define LDS_WAIT() asm volatile("s_waitcnt lgkmcnt(0)" ::: "memory")
__device__ __forceinline__ f32x4 mfma16(bf16x8 a, bf16x8 b, f32x4 c) { return __builtin_amdgcn_mfma_f32_16x16x32_bf16(a, b, c, 0, 0, 0); }
__device__ __forceinline__ f32x16 mfma32(bf16x8 a, bf16x8 b, f32x16 c) { return __builtin_amdgcn_mfma_f32_32x32x16_bf16(a, b, c, 0, 0, 0); }
__device__ __forceinline__ int crow(int r, int hi) { return (r & 3) + 8 * (r >> 2) + 4 * hi; }

__device__ __forceinline__ void transpose_item(const float* W, int ldw, int k0, int nsrc0, bf16_t* WT, int ldt, int ndst0, LAS float* scr, int lane) {
#pragma unroll 8
    for (int i = 0; i < 32; ++i) { const int kk = 2 * i + (lane >> 5); scr[kk * 33 + (lane & 31)] = W[(size_t)(k0 + kk) * ldw + nsrc0 + (lane & 31)]; }
    LDS_WAIT();
    const int c = lane & 7;
#pragma unroll
    for (int j = 0; j < 4; ++j) { const int n = (lane >> 3) + 8 * j; const LAS float* s = scr + (8 * c) * 33 + n;
        u32x4 o; o.x = pk_bf16(s[0 * 33], s[1 * 33]); o.y = pk_bf16(s[2 * 33], s[3 * 33]); o.z = pk_bf16(s[4 * 33], s[5 * 33]); o.w = pk_bf16(s[6 * 33], s[7 * 33]);
        *(u32x4*)(WT + (size_t)(ndst0 + n) * ldt + k0 + 8 * c) = o; }
    LDS_WAIT();
}

template <bool DO_LN, bool DO_GATES>
__device__ __forceinline__ void row_pass(const float* src, float* dstf, bf16_t* dstb, const float* g, const float* bt, const float* Wg, float* G, int gw, int ngw, int lane) {
    for (int m = gw; m < M; m += ngw) {
        const f32x4* xr = (const f32x4*)(src + (size_t)m * DM) + lane;
        f32x4 v[4];
#pragma unroll
        for (int j = 0; j < 4; ++j) v[j] = xr[64 * j];
        if (DO_LN) {
            float s = 0.f;
#pragma unroll
            for (int j = 0; j < 4; ++j) s += (v[j].x + v[j].y) + (v[j].z + v[j].w);
            const float mean = wave_sum(s) * (1.f / DM); float s2 = 0.f;
#pragma unroll
            for (int j = 0; j < 4; ++j) { v[j] = v[j] - mean; s2 += (v[j].x * v[j].x + v[j].y * v[j].y) + (v[j].z * v[j].z + v[j].w * v[j].w); }
            const float rstd = 1.f / sqrtf(wave_sum(s2) * (1.f / DM) + LN_EPS);
            f32x4* of = (f32x4*)(dstf + (size_t)m * DM) + lane;
#pragma unroll
            for (int j = 0; j < 4; ++j) { const f32x4 gg = ((const f32x4*)g)[lane + 64 * j], bb = ((const f32x4*)bt)[lane + 64 * j]; v[j] = v[j] * rstd * gg + bb; of[64 * j] = v[j]; }
        }
        u32x2* ob = (u32x2*)(dstb + (size_t)m * DM) + lane;
#pragma unroll
        for (int j = 0; j < 4; ++j) { u32x2 w; w.x = pk_bf16(v[j].x, v[j].y); w.y = pk_bf16(v[j].z, v[j].w); ob[64 * j] = w; }
        if (DO_GATES) {
            float keep = 0.f;
#pragma unroll
            for (int jg = 0; jg < 8; ++jg) { float s = 0.f;
#pragma unroll
                for (int j = 0; j < 4; ++j) { const f32x4 w = ((const f32x4*)(Wg + jg * DM))[lane + 64 * j]; s += (v[j].x * w.x + v[j].y * w.y) + (v[j].z * w.z + v[j].w * w.w); }
                s = wave_sum(s); if (lane == jg) keep = s; }
            if (lane < 8) G[(size_t)m * 8 + lane] = keep;
        }
    }
}

constexpr int AT_KB = 64 * 272, AT_VB = 64 * 256, AT_BUF = AT_KB + AT_VB;
__device__ __forceinline__ void attn_unit(LAS unsigned char* lds, const bf16_t* U, bf16_t* CAT, int b, int h, int qb, float lam, float out_scale, const float* gnorm, int tid) {
    asm volatile("" : "+v"(tid));
    const int lane = tid & 63, wid = __builtin_amdgcn_readfirstlane(tid >> 6), r32 = lane & 31, hi = lane >> 5;
    const int mp = wid >> 2, wq = wid & 3;
    const size_t rowbase = (size_t)b * SEQ;
    const int q0 = qb * 128 + wq * 32, qpos = q0 + r32;
    bf16x8 qf[4];
    { const bf16_t* qptr = U + (rowbase + qpos) * NU + UC_DQ + h * 128 + mp * 64 + hi * 8;
#pragma unroll
      for (int d0 = 0; d0 < 4; ++d0) qf[d0] = *(const bf16x8*)(qptr + 16 * d0); }
    const int nt = 2 * qb + 2;
    const bf16_t* kg = U + rowbase * NU + UC_DK + h * 128;
    const bf16_t* vg = U + rowbase * NU + UC_DV + h * 128;
    u32x4 kr[2], vr[2];
#define A_GLOAD(t) do { _Pragma("unroll") for (int i_ = 0; i_ < 2; ++i_) { const int c_ = tid + 512 * i_, row_ = c_ >> 4, ch_ = c_ & 15; \
        kr[i_] = *(const u32x4*)(kg + (size_t)(64 * (t) + row_) * NU + ch_ * 8); vr[i_] = *(const u32x4*)(vg + (size_t)(64 * (t) + row_) * NU + ch_ * 8); } } while (0)
#define A_LSTORE(bs) do { _Pragma("unroll") for (int i_ = 0; i_ < 2; ++i_) { const int c_ = tid + 512 * i_, row_ = c_ >> 4, ch_ = c_ & 15; \
        *(LAS u32x4*)(lds + (bs) * AT_BUF + row_ * 272 + ch_ * 16) = kr[i_]; \
        *(LAS u32x4*)(lds + (bs) * AT_BUF + AT_KB + ((row_ >> 3) * 4 + (ch_ >> 2)) * 512 + (row_ & 7) * 64 + (ch_ & 3) * 16) = vr[i_]; } } while (0)
    f32x16 o[4];
#pragma unroll
    for (int k = 0; k < 4; ++k)
#pragma unroll
        for (int r = 0; r < 16; ++r) o[k][r] = 0.f;
    float m_run = -INFINITY, l_run = 0.f;
    const float C = 0.125f * 1.4426950408889634f;
    const int vboff = (4 * hi + ((lane & 15) >> 2)) * 64 + ((lane >> 4) & 1) * 32 + (lane & 3) * 8;
    A_GLOAD(0); A_LSTORE(0); __syncthreads();
    for (int t = 0; t < nt; ++t) {
        if (t + 1 < nt) A_GLOAD(t + 1);
        if (64 * t <= q0 + 31) {
            const LAS unsigned char* Kb = lds + (t & 1) * AT_BUF; const LAS unsigned char* Vb = Kb + AT_KB;
            f32x16 s0, s1;
#pragma unroll
            for (int r = 0; r < 16; ++r) { s0[r] = 0.f; s1[r] = 0.f; }
#pragma unroll
            for (int d0 = 0; d0 < 4; ++d0) {
                const bf16x8 k0f = *(const LAS bf16x8*)(Kb + r32 * 272 + (mp * 64 + 16 * d0 + 8 * hi) * 2);
                const bf16x8 k1f = *(const LAS bf16x8*)(Kb + (r32 + 32) * 272 + (mp * 64 + 16 * d0 + 8 * hi) * 2);
                s0 = mfma32(k0f, qf[d0], s0); s1 = mfma32(k1f, qf[d0], s1);
            }
#pragma unroll
            for (int r = 0; r < 16; ++r) { s0[r] *= C; s1[r] *= C; }
            if (64 * t + 63 > q0) {
#pragma unroll
                for (int r = 0; r < 16; ++r) { const int key = 64 * t + crow(r, hi); if (key > qpos) s0[r] = -INFINITY; if (key + 32 > qpos) s1[r] = -INFINITY; }
            }
            float mx = fmaxf(s0[0], s1[0]);
#pragma unroll
            for (int r = 1; r < 16; ++r) mx = fmaxf(mx, fmaxf(s0[r], s1[r]));
            mx = fmaxf(mx, __shfl_xor(mx, 32));
            if (__any(mx > m_run + 8.f)) {
                const float mn = fmaxf(m_run, mx); const float f = exp2f(m_run - mn); m_run = mn; l_run *= f;
#pragma unroll
                for (int k = 0; k < 4; ++k)
#pragma unroll
                    for (int r = 0; r < 16; ++r) o[k][r] *= f;
            }
            float ls = 0.f;
#pragma unroll
            for (int r = 0; r < 16; ++r) { s0[r] = exp2f(s0[r] - m_run); s1[r] = exp2f(s1[r] - m_run); ls += s0[r] + s1[r]; }
            l_run += ls;
            bf16x8 pf[4];
            { u32x4 w;
              w.x = pk_bf16(s0[0], s0[1]); w.y = pk_bf16(s0[2], s0[3]); w.z = pk_bf16(s0[4], s0[5]); w.w = pk_bf16(s0[6], s0[7]); pf[0] = __builtin_bit_cast(bf16x8, w);
              w.x = pk_bf16(s0[8], s0[9]); w.y = pk_bf16(s0[10], s0[11]); w.z = pk_bf16(s0[12], s0[13]); w.w = pk_bf16(s0[14], s0[15]); pf[1] = __builtin_bit_cast(bf16x8, w);
              w.x = pk_bf16(s1[0], s1[1]); w.y = pk_bf16(s1[2], s1[3]); w.z = pk_bf16(s1[4], s1[5]); w.w = pk_bf16(s1[6], s1[7]); pf[2] = __builtin_bit_cast(bf16x8, w);
              w.x = pk_bf16(s1[8], s1[9]); w.y = pk_bf16(s1[10], s1[11]); w.z = pk_bf16(s1[12], s1[13]); w.w = pk_bf16(s1[14], s1[15]); pf[3] = __builtin_bit_cast(bf16x8, w); }
            const LAS unsigned char* vb = Vb + vboff;
#pragma unroll
            for (int blk = 0; blk < 4; ++blk)
#pragma unroll
                for (int ks = 0; ks < 4; ++ks) {
                    const s16x4 lo = __builtin_bit_cast(s16x4, __builtin_amdgcn_ds_read_tr16_b64_v4i16((LAS s16x4*)(vb + ks * 4096 + blk * 512)));
                    const s16x4 hh = __builtin_bit_cast(s16x4, __builtin_amdgcn_ds_read_tr16_b64_v4i16((LAS s16x4*)(vb + ks * 4096 + blk * 512 + 2048)));
                    const bf16x8 vf = {lo[0], lo[1], lo[2], lo[3], hh[0], hh[1], hh[2], hh[3]};
                    o[blk] = mfma32(vf, pf[ks], o[blk]);
                }
        }
        if (t + 1 < nt) A_LSTORE((t + 1) & 1);
        __syncthreads();
    }
#undef A_GLOAD
#undef A_LSTORE
    l_run += __shfl_xor(l_run, 32);
    const float inv = 1.f / l_run;
    LAS float* X = (LAS float*)lds + wq * 4096 + lane;
    if (mp == 1) {
        const float sc = inv * lam;
#pragma unroll
        for (int k = 0; k < 4; ++k)
#pragma unroll
            for (int r = 0; r < 16; ++r) X[(k * 16 + r) * 64] = o[k][r] * sc;
    }
    __syncthreads();
    if (mp == 0) {
        float ss = 0.f;
#pragma unroll
        for (int k = 0; k < 4; ++k)
#pragma unroll
            for (int r = 0; r < 16; ++r) { const float v = o[k][r] * inv - X[(k * 16 + r) * 64]; o[k][r] = v; ss += v * v; }
        ss += __shfl_xor(ss, 32);
        const float rn = out_scale / sqrtf(ss * (1.f / 128.f) + LN_EPS);
        bf16_t* orow = CAT + (rowbase + qpos) * DM + 512 + h * 128;
#pragma unroll
        for (int k = 0; k < 4; ++k)
#pragma unroll
            for (int r4 = 0; r4 < 4; ++r4) { const int dv = 32 * k + 8 * r4 + 4 * hi; const f32x4 g4 = *(const f32x4*)(gnorm + dv);
                u32x2 w; w.x = pk_bf16(o[k][4 * r4 + 0] * rn * g4.x, o[k][4 * r4 + 1] * rn * g4.y); w.y = pk_bf16(o[k][4 * r4 + 2] * rn * g4.z, o[k][4 * r4 + 3] * rn * g4.w);
                *(u32x2*)(orow + dv) = w; }
    }
    __syncthreads();
}

__device__ __forceinline__ void conv_unit(LAS unsigned char* lds, const bf16_t* U, bf16_t* CAT, int ct, const float* dw_w, const float* dw_b, const float* ln_g, const float* ln_b,
                                          const bf16_t* PwT, const float* pw_b, int tid) {
    asm volatile("" : "+v"(tid));
    const int lane = tid & 63, wid = __builtin_amdgcn_readfirstlane(tid >> 6);
    const int t0 = ct * 64, pos0 = t0 & (SEQ - 1);
    LAS float* Y = (LAS float*)lds;
    for (int id = tid; id < 94 * 32; id += NTHREADS) {
        const int r = id >> 5, c8 = id & 31; const int pos = pos0 - 30 + r;
        f32x4 y0 = {0.f, 0.f, 0.f, 0.f}, y1 = {0.f, 0.f, 0.f, 0.f};
        if (pos >= 0) {
            const bf16_t* up = U + (size_t)(t0 - 30 + r) * NU + 8 * c8;
            const u32x4 a = *(const u32x4*)(up + UC_CA), g = *(const u32x4*)(up + UC_CG);
            y0.x = bf_lo(a.x) * sigmoidf_(bf_lo(g.x)); y0.y = bf_hi(a.x) * sigmoidf_(bf_hi(g.x)); y0.z = bf_lo(a.y) * sigmoidf_(bf_lo(g.y)); y0.w = bf_hi(a.y) * sigmoidf_(bf_hi(g.y));
            y1.x = bf_lo(a.z) * sigmoidf_(bf_lo(g.z)); y1.y = bf_hi(a.z) * sigmoidf_(bf_hi(g.z)); y1.z = bf_lo(a.w) * sigmoidf_(bf_lo(g.w)); y1.w = bf_hi(a.w) * sigmoidf_(bf_hi(g.w));
        }
        *(LAS f32x4*)(Y + r * 256 + 8 * c8) = y0; *(LAS f32x4*)(Y + r * 256 + 8 * c8 + 4) = y1;
    }
    __syncthreads();
    f32x4 acc[8];
    { const f32x4 bias = *(const f32x4*)(dw_b + 4 * lane);
#pragma unroll
      for (int j = 0; j < 8; ++j) acc[j] = bias; }
#pragma unroll 1
    for (int tp = 0; tp < 31; ++tp) {
        const f32x4 w = *(const f32x4*)(dw_w + tp * 256 + 4 * lane);
        const LAS f32x4* yp = (const LAS f32x4*)(Y + (8 * wid + tp) * 256 + 4 * lane);
#pragma unroll
        for (int j = 0; j < 8; ++j) acc[j] += w * yp[j * 64];
    }
    { const f32x4 gg = *(const f32x4*)(ln_g + 4 * lane), bb = *(const f32x4*)(ln_b + 4 * lane);
#pragma unroll
      for (int j = 0; j < 8; ++j) {
        const float mean = wave_sum((acc[j].x + acc[j].y) + (acc[j].z + acc[j].w)) * (1.f / 256.f);
        f32x4 d = acc[j] - mean;
        const float var = wave_sum((d.x * d.x + d.y * d.y) + (d.z * d.z + d.w * d.w)) * (1.f / 256.f);
        const float rstd = 1.f / sqrtf(var + LN_EPS);
        d = d * rstd * gg + bb;
        d.x = d.x * sigmoidf_(d.x); d.y = d.y * sigmoidf_(d.y); d.z = d.z * sigmoidf_(d.z); d.w = d.w * sigmoidf_(d.w);
        acc[j] = d; } }
    __syncthreads();
    LAS unsigned char* At = lds;
#pragma unroll
    for (int j = 0; j < 8; ++j) { u32x2 w; w.x = pk_bf16(acc[j].x, acc[j].y); w.y = pk_bf16(acc[j].z, acc[j].w); *(LAS u32x2*)(At + (8 * wid + j) * 528 + lane * 8) = w; }
    __syncthreads();
    const int fr = lane & 15, fq = lane >> 4;
    f32x4 c[4][2];
#pragma unroll
    for (int mb = 0; mb < 4; ++mb)
#pragma unroll
        for (int nb = 0; nb < 2; ++nb) c[mb][nb] = (f32x4){0.f, 0.f, 0.f, 0.f};
#pragma unroll
    for (int ks = 0; ks < 8; ++ks) {
        bf16x8 bf[2], af[4];
#pragma unroll
        for (int nb = 0; nb < 2; ++nb) bf[nb] = *(const bf16x8*)(PwT + (size_t)(32 * wid + 16 * nb + fr) * 256 + 32 * ks + 8 * fq);
#pragma unroll
        for (int mb = 0; mb < 4; ++mb) af[mb] = *(const LAS bf16x8*)(At + (16 * mb + fr) * 528 + (32 * ks + 8 * fq) * 2);
#pragma unroll
        for (int mb = 0; mb < 4; ++mb)
#pragma unroll
            for (int nb = 0; nb < 2; ++nb) c[mb][nb] = mfma16(bf[nb], af[mb], c[mb][nb]);
    }
#pragma unroll
    for (int nb = 0; nb < 2; ++nb) { const int col = 32 * wid + 16 * nb + 4 * fq; const f32x4 bb = *(const f32x4*)(pw_b + col);
#pragma unroll
        for (int mb = 0; mb < 4; ++mb) { const f32x4 v = c[mb][nb] + bb; u32x2 w; w.x = pk_bf16(v.x, v.y); w.y = pk_bf16(v.z, v.w);
            *(u32x2*)(CAT + (size_t)(t0 + 16 * mb + fr) * DM + col) = w; } }
    __syncthreads();
}

constexpr int ML_Q = 0, ML_K = 18432, ML_VT = 36864, ML_KPT = 58624, ML_P = 76032, ML_CB = 110848, ML_SM = 122368;
__device__ __forceinline__ void mlstm_chain(LAS unsigned char* lds, const bf16_t* U, const float* G, bf16_t* CAT, int b, int h, const float* b_ig, const float* b_fg,
                                            const float* cw  , const float* cb  , const float* ng  , int tid_in) {
    const int wid = __builtin_amdgcn_readfirstlane(tid_in >> 6);
    LAS float* SM = (LAS float*)(lds + ML_SM);
    LAS float* sLI = SM, *sLF = SM + 128, *sROW = SM + 256, *sCOL = SM + 384, *sAI = SM + 512, *sEN = SM + 640, *sKS = SM + 768, *sRS = SM + 896, *sSC = SM + 1152;
    for (int i = tid_in; i < 80 * 72 / 2; i += NTHREADS) ((LAS unsigned*)(lds + ML_CB))[i] = 0u;
    for (int i = tid_in; i < 16 * 136 / 2; i += NTHREADS) ((LAS unsigned*)(lds + ML_VT + 64 * 272))[i] = (i < 68) ? 0x3f803f80u : 0u;
    f32x4 creg[3];
#pragma unroll
    for (int k = 0; k < 3; ++k) creg[k] = (f32x4){0.f, 0.f, 0.f, 0.f};
    float m_prev = 0.f;
    const float bi = b_ig[h], bff = b_fg[h];
    const size_t rowbase = (size_t)b * SEQ;
    __syncthreads();
    for (int ch = 0; ch < SEQ / 128; ++ch) {
        const size_t row0 = rowbase + (size_t)ch * 128;
        {
        int tid = tid_in; asm volatile("" : "+v"(tid)); const int lane = tid & 63, fr = lane & 15, fq = lane >> 4; (void)lane; (void)fr; (void)fq;
        if (tid < 128) {
            const float gi = G[(row0 + tid) * 8 + h] + bi, gf = G[(row0 + tid) * 8 + 4 + h] + bff;
            sLI[tid] = gi; sLF[tid] = fminf(gf, 0.f) - log1pf(__expf(-fabsf(gf)));
        }
#pragma unroll 1
        for (int i = 0; i < 4; ++i) {
            const int id = tid + 512 * i, j = id >> 4, cgp = id & 15;
            const int c0 = (cgp < 8) ? (64 * h + 8 * cgp) : (256 + 64 * h + 8 * (cgp - 8));
            float y[8];
            { const f32x4 b0 = *(const f32x4*)(cb + c0), b1 = *(const f32x4*)(cb + c0 + 4); y[0] = b0.x; y[1] = b0.y; y[2] = b0.z; y[3] = b0.w; y[4] = b1.x; y[5] = b1.y; y[6] = b1.z; y[7] = b1.w; }
#pragma unroll
            for (int tp = 0; tp < 4; ++tp) {
                const int pos = ch * 128 + j - 3 + tp;
                if (pos >= 0) {
                    const u32x4 x = *(const u32x4*)(U + (rowbase + pos) * NU + UC_MQK + c0);
                    const f32x4 w0 = *(const f32x4*)(cw + tp * 512 + c0), w1 = *(const f32x4*)(cw + tp * 512 + c0 + 4);
                    y[0] += w0.x * bf_lo(x.x); y[1] += w0.y * bf_hi(x.x); y[2] += w0.z * bf_lo(x.y); y[3] += w0.w * bf_hi(x.y);
                    y[4] += w1.x * bf_lo(x.z); y[5] += w1.y * bf_hi(x.z); y[6] += w1.z * bf_lo(x.w); y[7] += w1.w * bf_hi(x.w);
                }
            }
            const float sc = (cgp < 8) ? 1.f : 0.125f;
#pragma unroll
            for (int e = 0; e < 8; ++e) y[e] = y[e] * sigmoidf_(y[e]) * sc;
            u32x4 w; w.x = pk_bf16(y[0], y[1]); w.y = pk_bf16(y[2], y[3]); w.z = pk_bf16(y[4], y[5]); w.w = pk_bf16(y[6], y[7]);
            *(LAS u32x4*)(lds + ((cgp < 8) ? ML_Q : ML_K) + j * 144 + (cgp & 7) * 16) = w;
        }
#pragma unroll 1
        for (int i = 0; i < 2; ++i) {
            const int id = tid + 512 * i, s = id & 127, vg8 = id >> 7;
            const u32x4 x = *(const u32x4*)(U + (row0 + s) * NU + UC_MV + 64 * h + 8 * vg8);
            LAS bf16_t* vt = (LAS bf16_t*)(lds + ML_VT) + (8 * vg8) * 136 + s;
            vt[0 * 136] = (bf16_t)(x.x & 0xffffu); vt[1 * 136] = (bf16_t)(x.x >> 16); vt[2 * 136] = (bf16_t)(x.y & 0xffffu); vt[3 * 136] = (bf16_t)(x.y >> 16);
            vt[4 * 136] = (bf16_t)(x.z & 0xffffu); vt[5 * 136] = (bf16_t)(x.z >> 16); vt[6 * 136] = (bf16_t)(x.w & 0xffffu); vt[7 * 136] = (bf16_t)(x.w >> 16);
        }
        }
        __syncthreads();
        if (wid == 0) {
        int tid = tid_in; asm volatile("" : "+v"(tid)); const int lane = tid & 63, fr = lane & 15, fq = lane >> 4; (void)lane; (void)fr; (void)fq;
            const float lf0 = sLF[2 * lane], lf1 = sLF[2 * lane + 1], li0 = sLI[2 * lane], li1 = sLI[2 * lane + 1];
            const float c1 = lf0 + lf1; float tot = c1;
#pragma unroll
            for (int o = 1; o < 64; o <<= 1) { const float t = __shfl_up(tot, o); if (lane >= o) tot += t; }
            const float excl = tot - c1; const float b0 = excl + lf0, b1 = excl + c1;
            const float g = __shfl(tot, 63);
            const float ct0 = li0 - b0, ct1 = li1 - b1;
            const float pm1 = fmaxf(ct0, ct1); float sm = pm1;
#pragma unroll
            for (int o = 1; o < 64; o <<= 1) { const float t = __shfl_up(sm, o); if (lane >= o) sm = fmaxf(sm, t); }
            float ex = __shfl_up(sm, 1); if (lane == 0) ex = -INFINITY;
            const float pmax0 = fmaxf(ex, ct0), pmax1 = fmaxf(ex, pm1);
            const float pall = __shfl(sm, 63);
            const float m_loc = g + pall, m_new = fmaxf(g + m_prev, m_loc);
            const float M0 = fmaxf(m_prev, pmax0), M1 = fmaxf(m_prev, pmax1);
            sROW[2 * lane] = -M0; sROW[2 * lane + 1] = -M1;
            sCOL[2 * lane] = ct0; sCOL[2 * lane + 1] = ct1;
            sAI[2 * lane] = __expf(m_prev - M0); sAI[2 * lane + 1] = __expf(m_prev - M1);
            sEN[2 * lane] = __expf(-(b0 + M0)); sEN[2 * lane + 1] = __expf(-(b1 + M1));
            sKS[2 * lane] = __expf(g + ct0 - m_new); sKS[2 * lane + 1] = __expf(g + ct1 - m_new);
            if (lane == 0) { sSC[0] = __expf(g + m_prev - m_new); sSC[1] = m_new; }
        }
        __syncthreads();
        const float a_dec = sSC[0]; m_prev = sSC[1];
        {
        int tid = tid_in; asm volatile("" : "+v"(tid)); const int lane = tid & 63, fr = lane & 15, fq = lane >> 4; (void)lane; (void)fr; (void)fq;
            const int j = 16 * wid + fr;
            bf16x8 qfr[2];
#pragma unroll
            for (int ks = 0; ks < 2; ++ks) qfr[ks] = *(const LAS bf16x8*)(lds + ML_Q + j * 144 + (32 * ks + 8 * fq) * 2);
            const float rowt = sROW[j]; float rs = 0.f;
#pragma unroll
            for (int sb = 0; sb < 8; ++sb) {
                f32x4 sacc = {0.f, 0.f, 0.f, 0.f};
#pragma unroll
                for (int ks = 0; ks < 2; ++ks) { const bf16x8 kf = *(const LAS bf16x8*)(lds + ML_K + (16 * sb + fr) * 144 + (32 * ks + 8 * fq) * 2); sacc = mfma16(kf, qfr[ks], sacc); }
                const int s0 = 16 * sb + 4 * fq; float p[4];
#pragma unroll
                for (int e = 0; e < 4; ++e) { const int s = s0 + e; const float v = sacc[e] * __expf(rowt + sCOL[s]); p[e] = (s <= j) ? v : 0.f; rs += p[e]; }
                u32x2 w; w.x = pk_bf16(p[0], p[1]); w.y = pk_bf16(p[2], p[3]);
                *(LAS u32x2*)(lds + ML_P + j * 272 + s0 * 2) = w;
            }
            rs += __shfl_xor(rs, 16); rs += __shfl_xor(rs, 32);
            if (fq == 0) sRS[j] = rs;
            const int s = tid & 127, kg4 = tid >> 7;
            const float ksc = sKS[s];
            const u32x4 x0 = *(const LAS u32x4*)(lds + ML_K + s * 144 + kg4 * 32), x1 = *(const LAS u32x4*)(lds + ML_K + s * 144 + kg4 * 32 + 16);
            LAS bf16_t* kp = (LAS bf16_t*)(lds + ML_KPT) + (16 * kg4) * 136 + s;
            kp[0 * 136] = f2bf(bf_lo(x0.x) * ksc); kp[1 * 136] = f2bf(bf_hi(x0.x) * ksc); kp[2 * 136] = f2bf(bf_lo(x0.y) * ksc); kp[3 * 136] = f2bf(bf_hi(x0.y) * ksc);
            kp[4 * 136] = f2bf(bf_lo(x0.z) * ksc); kp[5 * 136] = f2bf(bf_hi(x0.z) * ksc); kp[6 * 136] = f2bf(bf_lo(x0.w) * ksc); kp[7 * 136] = f2bf(bf_hi(x0.w) * ksc);
            kp[8 * 136] = f2bf(bf_lo(x1.x) * ksc); kp[9 * 136] = f2bf(bf_hi(x1.x) * ksc); kp[10 * 136] = f2bf(bf_lo(x1.y) * ksc); kp[11 * 136] = f2bf(bf_hi(x1.y) * ksc);
            kp[12 * 136] = f2bf(bf_lo(x1.z) * ksc); kp[13 * 136] = f2bf(bf_hi(x1.z) * ksc); kp[14 * 136] = f2bf(bf_lo(x1.w) * ksc); kp[15 * 136] = f2bf(bf_hi(x1.w) * ksc);
        }
        LDS_WAIT();
        {
        int tid = tid_in; asm volatile("" : "+v"(tid)); const int lane = tid & 63, fr = lane & 15, fq = lane >> 4; (void)lane; (void)fr; (void)fq;
            f32x4 acc[5];
#pragma unroll
            for (int vb = 0; vb < 5; ++vb) acc[vb] = (f32x4){0.f, 0.f, 0.f, 0.f};
#pragma unroll
            for (int ks = 0; ks < 2; ++ks) {
                const bf16x8 qa = *(const LAS bf16x8*)(lds + ML_Q + (16 * wid + fr) * 144 + (32 * ks + 8 * fq) * 2);
#pragma unroll
                for (int vb = 0; vb < 5; ++vb) { const bf16x8 cf = *(const LAS bf16x8*)(lds + ML_CB + (16 * vb + fr) * 144 + (32 * ks + 8 * fq) * 2); acc[vb] = mfma16(qa, cf, acc[vb]); }
            }
            const int jb = 16 * wid + 4 * fq;
            float ai[4], den[4];
#pragma unroll
            for (int e = 0; e < 4; ++e) ai[e] = sAI[jb + e];
#pragma unroll
            for (int vb = 0; vb < 5; ++vb)
#pragma unroll
                for (int e = 0; e < 4; ++e) acc[vb][e] *= ai[e];
#pragma unroll
            for (int e = 0; e < 4; ++e) { const float nq = __shfl(acc[4][e], lane & 48); den[e] = nq + sRS[jb + e]; den[e] = fmaxf(fabsf(den[e]), sEN[jb + e]); }
#pragma unroll
            for (int ks = 0; ks < 4; ++ks) {
                const bf16x8 pa = *(const LAS bf16x8*)(lds + ML_P + (16 * wid + fr) * 272 + (32 * ks + 8 * fq) * 2);
#pragma unroll
                for (int vb = 0; vb < 4; ++vb) { const bf16x8 vf = *(const LAS bf16x8*)(lds + ML_VT + (16 * vb + fr) * 272 + (32 * ks + 8 * fq) * 2); acc[vb] = mfma16(pa, vf, acc[vb]); }
            }
#pragma unroll
            for (int e = 0; e < 4; ++e) {
                const size_t row = row0 + jb + e;
                float hv[4]; float s = 0.f;
#pragma unroll
                for (int vb = 0; vb < 4; ++vb) { const float og = sigmoidf_(bf2f(U[row * NU + UC_MO + 64 * h + 16 * vb + fr])); hv[vb] = acc[vb][e] / den[e] * og; s += hv[vb]; }
                s += __shfl_xor(s, 1); s += __shfl_xor(s, 2); s += __shfl_xor(s, 4); s += __shfl_xor(s, 8);
                const float mean = s * (1.f / 64.f); float q = 0.f;
#pragma unroll
                for (int vb = 0; vb < 4; ++vb) { hv[vb] -= mean; q += hv[vb] * hv[vb]; }
                q += __shfl_xor(q, 1); q += __shfl_xor(q, 2); q += __shfl_xor(q, 4); q += __shfl_xor(q, 8);
                const float rstd = 1.f / sqrtf(q * (1.f / 64.f) + LN_EPS);
#pragma unroll
                for (int vb = 0; vb < 4; ++vb) CAT[row * DM + 256 + 64 * h + 16 * vb + fr] = f2bf(hv[vb] * rstd * ng[64 * h + 16 * vb + fr]);
            }
        }
        __syncthreads();
        {
        int tid = tid_in; asm volatile("" : "+v"(tid)); const int lane = tid & 63, fr = lane & 15, fq = lane >> 4; (void)lane; (void)fr; (void)fq;
#pragma unroll
        for (int k = 0; k < 3; ++k) {
            const int bi_ = wid + 8 * k;
            if (bi_ < 20) {
                const int rb = bi_ >> 2, kb = bi_ & 3;
                f32x4 c = creg[k] * a_dec;
#pragma unroll
                for (int ks = 0; ks < 4; ++ks) {
                    const bf16x8 va = *(const LAS bf16x8*)(lds + ML_VT + (16 * rb + fr) * 272 + (32 * ks + 8 * fq) * 2);
                    const bf16x8 kf = *(const LAS bf16x8*)(lds + ML_KPT + (16 * kb + fr) * 272 + (32 * ks + 8 * fq) * 2);
                    c = mfma16(va, kf, c);
                }
                creg[k] = c;
                LAS bf16_t* cbp = (LAS bf16_t*)(lds + ML_CB) + (16 * rb + 4 * fq) * 72 + 16 * kb + fr;
                cbp[0] = f2bf(c[0]); cbp[72] = f2bf(c[1]); cbp[144] = f2bf(c[2]); cbp[216] = f2bf(c[3]);
            }
        }
        }
        __syncthreads();
    }
}

template <int l> __device__ __forceinline__ void run_layer(const Args& args, LAS unsigned char* lds, cg::grid_group& grid) {
    const int tid = threadIdx.x, lane = tid & 63, wid = __builtin_amdgcn_readfirstlane(tid >> 6);
    const int G = gridDim.x, bx = blockIdx.x;
    const int gw = bx * NWAVES + wid, ngw = G * NWAVES;
    unsigned char* ws = args.ws;
    unsigned* ctl = (unsigned*)(ws + WS_CTL);
    bf16_t* WinT = (bf16_t*)(ws + WS_WIN); bf16_t* WoT = (bf16_t*)(ws + WS_WOUT); bf16_t* WupT = (bf16_t*)(ws + WS_WUP); bf16_t* WdT = (bf16_t*)(ws + WS_WDN);
    bf16_t* PwT = (bf16_t*)(ws + WS_PW); float* Wg = (float*)(ws + WS_WG); float* Gt = (float*)(ws + WS_G);
    bf16_t* XB = (bf16_t*)(ws + WS_XB); bf16_t* CAT = (bf16_t*)(ws + WS_CAT); bf16_t* Ub = (bf16_t*)(ws + WS_U); bf16_t* HID = (bf16_t*)(ws + WS_U);
    float* out = args.out;
    const float* x_in = args.in[0];
        {
            pg8::Gemm g{XB, WinT + (size_t)l * NU * DM, M, NU, DM}; pg8::StaticOrder S; S.init(M, NU, G, bx);
            pg8::EpiBf16<0> E{Ub, NU};
            pg8::gemm_phase<pg8::EpiBf16<0>, pg8::StaticOrder, true, true>(lds, g, S, E);
        }
        grid.sync();
        {
            const float lam = ((const float*)ctl)[128 + l];
            const float linit = 0.8f - 0.6f * expf(-0.3f * (float)l);
            LAS int* sitem = (LAS int*)(lds + 140 * 1024);
            constexpr int N_ML = 16, N_AT = 1024, N_CV = 512, N_ALL = N_ML + N_AT + N_CV;
#define FETCH_ITEM() do { if (tid == 0) sitem[0] = (int)atomicAdd(ctl + 64 * l, 1u); __syncthreads(); item = sitem[0]; __syncthreads(); } while (0)
            int item; FETCH_ITEM();
            while (item < N_ML) {
                mlstm_chain(lds, Ub, Gt, CAT, item >> 2, item & 3, args.in[2] + l * 4, args.in[3] + l * 4, args.in[10] + l * 2048, args.in[11] + l * 512, args.in[12] + l * 256, tid);
                FETCH_ITEM();
            }
            while (item < N_ML + N_AT) {
                const int idx = item - N_ML; const int qb = 63 - (idx >> 4), bh = idx & 15;
                attn_unit(lds, Ub, CAT, bh >> 2, bh & 3, qb, lam, 1.f - linit, args.in[17] + l * 128, tid);
                FETCH_ITEM();
            }
            while (item < N_ALL) {
                conv_unit(lds, Ub, CAT, item - N_ML - N_AT, args.in[4] + l * 31 * 256, args.in[5] + l * 256, args.in[6] + l * 256, args.in[7] + l * 256, PwT + (size_t)l * 65536, args.in[9] + l * 256, tid);
                FETCH_ITEM();
            }
#undef FETCH_ITEM
        }
        grid.sync();
        {
            pg8::Gemm g{CAT, WoT + (size_t)l * DM * DM, M, DM, DM}; pg8::StaticOrder S; S.init(M, DM, G, bx);
            pg8::EpiRes E{(l == 0) ? x_in : (const float*)out, out, DM, ALPHA};
            pg8::gemm_phase<pg8::EpiRes, pg8::StaticOrder, true, true>(lds, g, S, E);
        }
        grid.sync();
        row_pass<true, false>(out, out, XB, args.in[19] + l * DM, args.in[20] + l * DM, nullptr, nullptr, gw, ngw, lane);
        grid.sync();
        {
            pg8::Gemm g{XB, WupT + (size_t)l * DFF * DM, M, DFF, DM}; pg8::StaticOrder S; S.init(M, DFF, G, bx);
            pg8::EpiBf16<2> E{HID, DFF};
            pg8::gemm_phase<pg8::EpiBf16<2>, pg8::StaticOrder, true, true>(lds, g, S, E);
        }
        grid.sync();
        {
            pg8::Gemm g{HID, WdT + (size_t)l * DM * DFF, M, DM, DFF}; pg8::StaticOrder S; S.init(M, DM, G, bx);
            pg8::EpiRes E{(const float*)out, out, DM, ALPHA};
            pg8::gemm_phase<pg8::EpiRes, pg8::StaticOrder, true, true>(lds, g, S, E);
        }
        grid.sync();
        if (l == 0) row_pass<true, true>(out, out, XB, args.in[23] + l * DM, args.in[24] + l * DM, Wg + 8 * DM, Gt, gw, ngw, lane);
        else row_pass<true, false>(out, out, XB, args.in[23] + l * DM, args.in[24] + l * DM, nullptr, nullptr, gw, ngw, lane);
        if (l == 0) grid.sync();
}

__global__ void __launch_bounds__(NTHREADS) hymba_fwd(Args args) {
    extern __shared__ __attribute__((aligned(16))) unsigned char lds_raw[];
    LAS unsigned char* lds = (LAS unsigned char*)lds_raw;
    cg::grid_group grid = cg::this_grid();
    const int tid = threadIdx.x, lane = tid & 63, wid = __builtin_amdgcn_readfirstlane(tid >> 6);
    const int G = gridDim.x, bx = blockIdx.x;
    const int gw = bx * NWAVES + wid, ngw = G * NWAVES;
    unsigned char* ws = args.ws;
    unsigned* ctl = (unsigned*)(ws + WS_CTL);
    bf16_t* WinT = (bf16_t*)(ws + WS_WIN); bf16_t* WoT = (bf16_t*)(ws + WS_WOUT); bf16_t* WupT = (bf16_t*)(ws + WS_WUP); bf16_t* WdT = (bf16_t*)(ws + WS_WDN);
    bf16_t* PwT = (bf16_t*)(ws + WS_PW); float* Wg = (float*)(ws + WS_WG); float* Gt = (float*)(ws + WS_G);
    bf16_t* XB = (bf16_t*)(ws + WS_XB); bf16_t* CAT = (bf16_t*)(ws + WS_CAT); bf16_t* Ub = (bf16_t*)(ws + WS_U); bf16_t* HID = (bf16_t*)(ws + WS_U);
    float* out = args.out;
    const float* x_in = args.in[0];

    {
        LAS float* scr = (LAS float*)(lds + wid * 16384);
        constexpr int I_IN = 16 * 96, I_O = 16 * 32, I_UP = 16 * 128, I_DN = 64 * 32, I_PW = 4 * 8, I_L = I_IN + I_O + I_UP + I_DN + I_PW;
        for (int it = gw; it < 2 * I_L; it += ngw) {
            const int l = it / I_L; int r = it % I_L;
            if (r < I_IN) { const int kb = r / 96, nb = r % 96, n0 = 32 * nb; transpose_item(args.in[1] + (size_t)l * DM * NIN, NIN, 64 * kb, n0 + (n0 >= 1536 ? 8 : 0), WinT + (size_t)l * NU * DM, DM, n0, scr, lane); continue; } r -= I_IN;
            if (r < I_O) { const int kb = r / 32, nb = r % 32; transpose_item(args.in[18] + (size_t)l * DM * DM, DM, 64 * kb, 32 * nb, WoT + (size_t)l * DM * DM, DM, 32 * nb, scr, lane); continue; } r -= I_O;
            if (r < I_UP) { const int kb = r / 128, nb = r % 128; transpose_item(args.in[21] + (size_t)l * DM * DFF, DFF, 64 * kb, 32 * nb, WupT + (size_t)l * DFF * DM, DM, 32 * nb, scr, lane); continue; } r -= I_UP;
            if (r < I_DN) { const int kb = r / 32, nb = r % 32; transpose_item(args.in[22] + (size_t)l * DFF * DM, DM, 64 * kb, 32 * nb, WdT + (size_t)l * DM * DFF, DFF, 32 * nb, scr, lane); continue; } r -= I_DN;
            { const int kb = r / 8, nb = r % 8; transpose_item(args.in[8] + (size_t)l * 65536, 256, 64 * kb, 32 * nb, PwT + (size_t)l * 65536, 256, 32 * nb, scr, lane); }
        }
        for (int i = bx * NTHREADS + tid; i < 2 * 8 * DM; i += G * NTHREADS) { const int l = i >> 13, jg = (i >> 10) & 7, k = i & 1023; Wg[i] = args.in[1][(size_t)l * DM * NIN + (size_t)k * NIN + 1536 + jg]; }
        if (bx == 0 && wid == 0) {
#pragma unroll
            for (int l = 0; l < 2; ++l) {
                const float s1 = wave_sum(args.in[13][l * 64 + lane] * args.in[14][l * 64 + lane]);
                const float s2 = wave_sum(args.in[15][l * 64 + lane] * args.in[16][l * 64 + lane]);
                const float linit = 0.8f - 0.6f * expf(-0.3f * (float)l);
                if (lane == 0) ((float*)ctl)[128 + l] = expf(s1) - expf(s2) + linit;
            }
        }
    }
    grid.sync();
    row_pass<false, true>(x_in, nullptr, XB, nullptr, nullptr, Wg, Gt, gw, ngw, lane);
    grid.sync();

    run_layer<0>(args, lds, grid);
    run_layer<1>(args, lds, grid);
}

extern "C" void kernel_launch(void* const* d_in, const int* in_sizes, int n_in, void* d_out, int out_size, void* d_ws, size_t ws_size, hipStream_t stream) {
    static int grid = 0;
    if (grid == 0) {
        if (n_in != 25 || out_size != M * DM || ws_size < WS_END) { fprintf(stderr, "kernel_launch: unexpected shapes (n_in %d out %d ws %zu)\n", n_in, out_size, ws_size); grid = -1; return; }
        int dev = 0, cus = 0, per_cu = 0;
        hipGetDevice(&dev); hipDeviceGetAttribute(&cus, hipDeviceAttributeMultiprocessorCount, dev);
        if (hipFuncSetAttribute((const void*)hymba_fwd, hipFuncAttributeMaxDynamicSharedMemorySize, LDS_BYTES) != hipSuccess) { fprintf(stderr, "kernel_launch: hipFuncSetAttribute failed\n"); grid = -1; return; }
        if (hipOccupancyMaxActiveBlocksPerMultiprocessor(&per_cu, (const void*)hymba_fwd, NTHREADS, LDS_BYTES) != hipSuccess || per_cu < 1) { fprintf(stderr, "kernel_launch: occupancy query failed (%d)\n", per_cu); per_cu = 1; }
        (void)hipGetLastError();
        grid = cus * per_cu;
        if (grid > 256) grid = 256;
    }
    if (grid < 0) return;
    hipMemsetAsync((char*)d_ws + WS_CTL, 0, CTL_BYTES, stream);
    Args a{};
    for (int i = 0; i < 25; ++i) a.in[i] = (const float*)d_in[i];
    a.out = (float*)d_out; a.ws = (unsigned char*)d_ws;
    void* kargs[] = {&a};
    hipError_t e = hipLaunchCooperativeKernel((const void*)hymba_fwd, dim3(grid), dim3(NTHREADS), kargs, LDS_BYTES, stream);
    if (e != hipSuccess) fprintf(stderr, "cooperative launch failed: %s (grid %d)\n", hipGetErrorString(e), grid);
}
```

```cpp
#include <hip/hip_runtime.h>
#include <hip/hip_cooperative_groups.h>
#include <cstdio>
#include <cstdint>
#include <cmath>
namespace cg = cooperative_groups;
namespace pg8 {
#define PG8_LAS __attribute__((address_space(3)))
typedef unsigned short bf16_t;
typedef short bf16x8 __attribute__((ext_vector_type(8)));
typedef float f32x4 __attribute__((ext_vector_type(4)));
typedef unsigned u32x4 __attribute__((ext_vector_type(4)));
constexpr int BM = 256, BK = 64, HALF = 128, HTB = HALF * BK * 2  , STAGE_BYTES = 8 * HTB, NXCD = 8, WGM = 8;

__host__ __device__ __forceinline__ int lds_byte(int r, int c) { const int st = (r >> 4) * 2 + (c >> 5), rr = r & 15, cc = c & 31, ob = rr * 64 + cc * 2; return st * 1024 + (ob ^ (((ob >> 9) & 1) << 5)); }
__host__ __device__ __forceinline__ void stage_rc(int b, int& R, int& C) { const int st = b / 1024, sb = b % 1024, swz = sb ^ (((sb >> 9) & 1) << 5); R = (st >> 1) * 16 + swz / 64; C = (st & 1) * 32 + (swz % 64) / 2; }
__host__ __device__ __forceinline__ int perm32(int rho) { const int n = rho >> 4, i = rho & 15; return 8 * (i >> 2) + 4 * n + (i & 3); }

struct Unit { int pm, pn; };
struct Gemm { const bf16_t* A; const bf16_t* Bt; int M, N, K; };

struct StaticOrder {
    int nM, nN, nwg, G, c;
    __host__ __device__ void init(int M, int N, int G_, int c_) { nM = M / BM; nN = N / BM; nwg = nM * nN; G = G_; c = c_; }
    __host__ __device__ bool next(int i, Unit& u) const {
        const long L = (long)i * G + c; if (L >= nwg) return false;
        int wgid = (int)L; { const int q = nwg / NXCD, r = nwg % NXCD, xcd = wgid % NXCD, off = wgid / NXCD; wgid = (xcd < r ? xcd * (q + 1) : r * (q + 1) + (xcd - r) * q) + off; }
        const int nig = WGM * nN, gid = wgid / nig, fm = gid * WGM, gsz = (nM - fm) < WGM ? (nM - fm) : WGM;
        u.pm = fm + ((wgid % nig) % gsz); u.pn = (wgid % nig) / gsz; return true;
    }
    __device__ __forceinline__ void a_ready(const Unit&) const {}
    __device__ __forceinline__ void done(const Unit&) const {}
};
__device__ __forceinline__ unsigned cvt_pk_bf16(float lo, float hi) { unsigned r; asm volatile("v_cvt_pk_bf16_f32 %0, %1, %2" : "=v"(r) : "v"(lo), "v"(hi)); return r; }
typedef float f32x2 __attribute__((ext_vector_type(2)));
template <int ACT  > struct EpiBf16 {
    static constexpr bool PERM = true, AFTER_DRAIN = false;
    bf16_t* O; int ldc;
    __device__ __forceinline__ void operator()(const f32x4 (&acc)[2][2][4][2], const Unit& u, int wr, int wc, int fr, int fq) const {
        const int row0 = u.pm * BM + wr * 64 + fr; const int col0 = u.pn * BM + wc * 32 + 8 * fq;
#pragma unroll
        for (int ai = 0; ai < 2; ++ai)
#pragma unroll
            for (int m = 0; m < 4; ++m) { bf16_t* rowp = O + (size_t)(row0 + ai * HALF + m * 16) * ldc + col0;
#pragma unroll
                for (int bj = 0; bj < 2; ++bj) { f32x4 v0 = acc[ai][bj][m][0], v1 = acc[ai][bj][m][1];
                    if (ACT == 2) {
#pragma unroll
                        for (int e = 0; e < 4; ++e) { const float a = fmaxf(v0[e], 0.f), b = fmaxf(v1[e], 0.f); v0[e] = a * a; v1[e] = b * b; } }
                    u32x4 w; w.x = cvt_pk_bf16(v0[0], v0[1]); w.y = cvt_pk_bf16(v0[2], v0[3]); w.z = cvt_pk_bf16(v1[0], v1[1]); w.w = cvt_pk_bf16(v1[2], v1[3]);
                    *(u32x4*)(rowp + bj * HALF) = w; } }
    }
};
struct EpiRes {
    static constexpr bool PERM = false, AFTER_DRAIN = false;
    const float* base; float* out; int ldc; float alpha;
    __device__ __forceinline__ void operator()(const f32x4 (&acc)[2][2][4][2], const Unit& u, int wr, int wc, int fr, int fq) const {
        const int col0 = u.pn * BM + wc * 32 + 4 * fq;
#pragma unroll
        for (int ai = 0; ai < 2; ++ai)
#pragma unroll
            for (int m = 0; m < 4; ++m) { const int r = u.pm * BM + ai * HALF + wr * 64 + m * 16 + fr; const size_t off = (size_t)r * ldc + col0;
#pragma unroll
                for (int bj = 0; bj < 2; ++bj)
#pragma unroll
                    for (int n = 0; n < 2; ++n) { const f32x4 bs = *(const f32x4*)(base + off + bj * HALF + n * 16); const f32x4 o = bs * alpha + acc[ai][bj][m][n];
                        *(f32x4*)(out + off + bj * HALF + n * 16) = o; }
                asm volatile("" ::: "memory"); }
    }
};
template <class Epi, class Sched, bool ALIGN_EPI = false, bool SP2 = false>
__device__ __forceinline__ void gemm_phase(PG8_LAS unsigned char* lds, const Gemm g, const Sched& S, const Epi& E) {
    const int tid = threadIdx.x, wid = __builtin_amdgcn_readfirstlane(tid >> 6), lane = tid & 63, wr = wid >> 2, wc = wid & 3, fr = lane & 15, fq = lane >> 4;
    const int K = g.K, nt = K / BK;
    unsigned voffA[2], voffB[2];
#pragma unroll
    for (int i = 0; i < 2; ++i) { int R, C; stage_rc(tid * 16 + i * 8192, R, C); const int Rb = Epi::PERM ? ((R & ~31) + perm32(R & 31)) : R;
        voffA[i] = (unsigned)(R * K + C) * 2u; voffB[i] = (unsigned)(Rb * K + C) * 2u; }
    const size_t kstep = (size_t)(BK * 2);
    const size_t hstep = (size_t)HALF * K * 2;
    const size_t tstep = 2 * hstep;
    const unsigned ldsw = (unsigned)wid * 1024u;
    const int aoff = lds_byte(wr * 64 + fr, fq * 8), boff = lds_byte(wc * 32 + fr, fq * 8);
#define PG8_SA(b, h) (((b) * 2 + (h)) * HTB)
#define PG8_SB(b, h) ((4 + (b) * 2 + (h)) * HTB)
#define PG8_STAGE(bufoff, gbase, voff) do { _Pragma("unroll") for (int _i = 0; _i < 2; ++_i) \
        __builtin_amdgcn_global_load_lds((const unsigned*)((const char*)(gbase) + (voff)[_i]), (PG8_LAS unsigned*)(lds + (bufoff) + ldsw + _i * 8192), 16, 0, 0); } while (0)
#define PG8_LDA(dst, b, h) do { _Pragma("unroll") for (int m = 0; m < 4; ++m) _Pragma("unroll") for (int k = 0; k < 2; ++k) dst[m][k] = *(const PG8_LAS bf16x8*)(lds + PG8_SA(b, h) + aoff + m * 2048 + k * 1024); } while (0)
#define PG8_LDB(dst, b, h) do { _Pragma("unroll") for (int n = 0; n < 2; ++n) _Pragma("unroll") for (int k = 0; k < 2; ++k) dst[n][k] = *(const PG8_LAS bf16x8*)(lds + PG8_SB(b, h) + boff + n * 2048 + k * 1024); } while (0)
#define PG8_MMA(ai, bj, At, Bt) do { __builtin_amdgcn_s_setprio(1); _Pragma("unroll") for (int m = 0; m < 4; ++m) _Pragma("unroll") for (int n = 0; n < 2; ++n) _Pragma("unroll") for (int k = 0; k < 2; ++k) \
        acc[ai][bj][m][n] = __builtin_amdgcn_mfma_f32_16x16x32_bf16(Bt[n][k], At[m][k], acc[ai][bj][m][n], 0, 0, 0); __builtin_amdgcn_s_setprio(0); } while (0)
#define PG8_WAIT_V(n) asm volatile("s_waitcnt vmcnt(" #n ")" ::: "memory")
#define PG8_WAIT_L(n) asm volatile("s_waitcnt lgkmcnt(" #n ")" ::: "memory")
#define PG8_BAR __builtin_amdgcn_s_barrier()
#define PG8_SCHED __builtin_amdgcn_sched_barrier(0)
    Unit cur, nxt; int ui = 0;
    if (!S.next(0, cur)) return;
    f32x4 acc[2][2][4][2];
#pragma unroll
    for (int a = 0; a < 2; ++a)
#pragma unroll
        for (int b = 0; b < 2; ++b)
#pragma unroll
            for (int m = 0; m < 4; ++m)
#pragma unroll
                for (int n = 0; n < 2; ++n) acc[a][b][m][n] = (f32x4){0.f, 0.f, 0.f, 0.f};
    bf16x8 At[4][2], B0[2][2], B1[2][2];
    const char* cA = (const char*)g.A + (size_t)cur.pm * tstep; const char* cB = (const char*)g.Bt + (size_t)cur.pn * tstep;
    S.a_ready(cur);
    if constexpr (SP2) {
        PG8_STAGE(PG8_SB(0, 0), cB, voffB); PG8_STAGE(PG8_SB(0, 1), cB + hstep, voffB); PG8_STAGE(PG8_SA(0, 0), cA, voffA); PG8_STAGE(PG8_SA(0, 1), cA + hstep, voffA);
        if (wr == 1) PG8_BAR;
        PG8_WAIT_V(2); PG8_BAR;
        PG8_STAGE(PG8_SB(1, 0), cB + kstep, voffB); PG8_STAGE(PG8_SA(1, 0), cA + kstep, voffA); PG8_STAGE(PG8_SB(1, 1), cB + hstep + kstep, voffB);
        PG8_WAIT_V(6); PG8_BAR;
    } else {
        PG8_STAGE(PG8_SB(0, 0), cB, voffB); PG8_STAGE(PG8_SA(0, 0), cA, voffA); PG8_STAGE(PG8_SB(0, 1), cB + hstep, voffB); PG8_STAGE(PG8_SA(0, 1), cA + hstep, voffA);
        if (wr == 1) PG8_BAR;
        PG8_WAIT_V(4); PG8_BAR;
        PG8_STAGE(PG8_SB(1, 0), cB + kstep, voffB); PG8_STAGE(PG8_SA(1, 0), cA + kstep, voffA); PG8_STAGE(PG8_SB(1, 1), cB + hstep + kstep, voffB);
        PG8_WAIT_V(6); PG8_BAR;
    }
    for (;;) {
        const bool has_next = S.next(ui + 1, nxt);
        const char* nA = has_next ? (const char*)g.A + (size_t)nxt.pm * tstep : cA; const char* nB = has_next ? (const char*)g.Bt + (size_t)nxt.pn * tstep : cB;
        for (int t = 0; t < nt; t += 2) {
            const bool last = (t == nt - 2);
            const char* a1 = cA + (size_t)(t + 1) * kstep;
            const char* a2 = last ? nA : cA + (size_t)(t + 2) * kstep; const char* b2 = last ? nB : cB + (size_t)(t + 2) * kstep;
            const char* a3 = a2 + kstep; const char* b3 = b2 + kstep;
            if (last && has_next) S.a_ready(nxt);
            if constexpr (SP2) {
            PG8_LDB(B0, 0, 0); PG8_LDB(B1, 0, 1); PG8_SCHED; PG8_LDA(At, 0, 0); PG8_STAGE(PG8_SA(1, 1), a1 + hstep, voffA);
            PG8_WAIT_V(8); PG8_WAIT_L(0); PG8_BAR; PG8_MMA(0, 0, At, B0); PG8_MMA(0, 1, At, B1); PG8_BAR; PG8_SCHED;
            PG8_LDA(At, 0, 1); PG8_STAGE(PG8_SB(0, 0), b2, voffB); PG8_STAGE(PG8_SB(0, 1), b2 + hstep, voffB); PG8_STAGE(PG8_SA(0, 0), a2, voffA);
            PG8_WAIT_V(8); PG8_WAIT_L(0); PG8_BAR; PG8_MMA(1, 0, At, B0); PG8_MMA(1, 1, At, B1); PG8_BAR; PG8_SCHED;
            PG8_LDB(B0, 1, 0); PG8_LDB(B1, 1, 1); PG8_SCHED; PG8_LDA(At, 1, 0); PG8_STAGE(PG8_SA(0, 1), a2 + hstep, voffA);
            PG8_WAIT_V(8); PG8_WAIT_L(0); PG8_BAR; PG8_MMA(0, 0, At, B0); PG8_MMA(0, 1, At, B1); PG8_BAR; PG8_SCHED;
            PG8_LDA(At, 1, 1); PG8_STAGE(PG8_SB(1, 0), b3, voffB); PG8_STAGE(PG8_SB(1, 1), b3 + hstep, voffB); PG8_STAGE(PG8_SA(1, 0), a3, voffA);
            PG8_WAIT_V(8); PG8_WAIT_L(0); PG8_BAR; PG8_MMA(1, 0, At, B0); PG8_MMA(1, 1, At, B1); PG8_BAR; PG8_SCHED;
            } else {
            PG8_LDB(B0, 0, 0); PG8_SCHED; PG8_LDA(At, 0, 0); PG8_STAGE(PG8_SA(1, 1), a1 + hstep, voffA);
            PG8_WAIT_L(8); PG8_BAR; PG8_WAIT_L(0); PG8_MMA(0, 0, At, B0); PG8_BAR; PG8_SCHED;
            PG8_LDB(B1, 0, 1); PG8_STAGE(PG8_SB(0, 0), b2, voffB);
            PG8_BAR; PG8_WAIT_L(0); PG8_MMA(0, 1, At, B1); PG8_BAR;
            PG8_LDA(At, 0, 1); PG8_STAGE(PG8_SA(0, 0), a2, voffA);
            PG8_BAR; PG8_WAIT_L(0); PG8_MMA(1, 0, At, B0); PG8_BAR; PG8_SCHED;
            PG8_STAGE(PG8_SB(0, 1), b2 + hstep, voffB);
            PG8_WAIT_V(6); PG8_BAR; PG8_MMA(1, 1, At, B1); PG8_BAR;
            PG8_LDB(B0, 1, 0); PG8_SCHED; PG8_LDA(At, 1, 0); PG8_STAGE(PG8_SA(0, 1), a2 + hstep, voffA);
            PG8_WAIT_L(8); PG8_BAR; PG8_WAIT_L(0); PG8_MMA(0, 0, At, B0); PG8_BAR; PG8_SCHED;
            PG8_LDB(B1, 1, 1); PG8_STAGE(PG8_SB(1, 0), b3, voffB);
            PG8_BAR; PG8_WAIT_L(0); PG8_MMA(0, 1, At, B1); PG8_BAR;
            PG8_LDA(At, 1, 1); PG8_STAGE(PG8_SA(1, 0), a3, voffA);
            PG8_BAR; PG8_WAIT_L(0); PG8_MMA(1, 0, At, B0); PG8_BAR; PG8_SCHED;
            PG8_STAGE(PG8_SB(1, 1), b3 + hstep, voffB);
            PG8_WAIT_V(6); PG8_BAR; PG8_MMA(1, 1, At, B1); PG8_BAR;
            }
        }
        if constexpr (ALIGN_EPI) { if (wr == 0) PG8_BAR; }
        if constexpr (!Epi::AFTER_DRAIN) { E(acc, cur, wr, wc, fr, fq); S.done(cur); }
        if (!has_next) break;
#pragma unroll
        for (int a = 0; a < 2; ++a)
#pragma unroll
            for (int b = 0; b < 2; ++b)
#pragma unroll
                for (int m = 0; m < 4; ++m)
#pragma unroll
                    for (int n = 0; n < 2; ++n) acc[a][b][m][n] = (f32x4){0.f, 0.f, 0.f, 0.f};
        cur = nxt; cA = nA; cB = nB; ++ui;
        if constexpr (ALIGN_EPI) { if (wr == 1) PG8_BAR; }
    }
    PG8_WAIT_V(0);
    if constexpr (!ALIGN_EPI) { if (wr == 0) PG8_BAR; }
    PG8_BAR;
    if constexpr (Epi::AFTER_DRAIN) { E.fused(acc, cur, wr, wc, fr, fq, lds, wid, lane); S.done(cur); }
#undef PG8_SA
#undef PG8_SB
#undef PG8_STAGE
#undef PG8_LDA
#undef PG8_LDB
#undef PG8_MMA
#undef PG8_WAIT_V
#undef PG8_WAIT_L
#undef PG8_BAR
#undef PG8_SCHED
}
}

#define LAS __attribute__((address_space(3)))
typedef unsigned short bf16_t;
typedef short bf16x8 __attribute__((ext_vector_type(8)));
typedef short s16x4 __attribute__((ext_vector_type(4)));
typedef float f32x4 __attribute__((ext_vector_type(4)));
typedef float f32x16 __attribute__((ext_vector_type(16)));
typedef unsigned u32x4 __attribute__((ext_vector_type(4)));
typedef unsigned u32x2 __attribute__((ext_vector_type(2)));

constexpr int BATCH = 4, SEQ = 8192, DM = 1024, M = BATCH * SEQ, NU = 3072, DFF = 4096, NIN = 3080;
constexpr float LN_EPS = 1e-5f;
constexpr float ALPHA = 1.4142135623730951f;
constexpr int NTHREADS = 512, NWAVES = 8;
constexpr int LDS_BYTES = 147456;

constexpr size_t MiB = 1u << 20;
constexpr size_t WS_CTL = 0, CTL_BYTES = 65536;
constexpr size_t WS_WIN = 2 * MiB, WS_WOUT = 14 * MiB, WS_WUP = 18 * MiB, WS_WDN = 34 * MiB, WS_PW = 50 * MiB, WS_WG = 50 * MiB + 512 * 1024;
constexpr size_t WS_G = 51 * MiB, WS_XB = 52 * MiB, WS_CAT = 116 * MiB, WS_U = 180 * MiB, WS_END = 436 * MiB;
constexpr size_t WS_CL = 372 * MiB, WS_CP = 392 * MiB, WS_MS = 402 * MiB;

constexpr int UC_CA = 0, UC_CG = 256, UC_MQK = 512, UC_MV = 1024, UC_MO = 1280, UC_DQ = 1536, UC_DK = 2048, UC_DV = 2560;

struct Args { const float* in[25]; float* out; unsigned char* ws; };

__device__ __forceinline__ float wave_sum(float v) {
#pragma unroll
    for (int o = 1; o < 64; o <<= 1) v += __shfl_xor(v, o);
    return v;
}
__device__ __forceinline__ unsigned pk_bf16(float lo, float hi) { typedef float f2 __attribute__((ext_vector_type(2))); typedef __bf16 b2 __attribute__((ext_vector_type(2))); f2 v = {lo, hi}; b2 b = __builtin_convertvector(v, b2); return __builtin_bit_cast(unsigned, b); }
__device__ __forceinline__ float bf_lo(unsigned u) { return __uint_as_float(u << 16); }
__device__ __forceinline__ float bf_hi(unsigned u) { return __uint_as_float(u & 0xffff0000u); }
__device__ __forceinline__ float bf2f(bf16_t h) { return __uint_as_float(((unsigned)h) << 16); }
__device__ __forceinline__ bf16_t f2bf(float f) { return (bf16_t)(pk_bf16(f, 0.f) & 0xffffu); }
__device__ __forceinline__ float sigmoidf_(float x) { return 1.f / (1.f + __expf(-x)); }
#define LDS_WAIT() asm volatile("s_waitcnt lgkmcnt(0)" ::: "memory")
__device__ __forceinline__ f32x4 mfma16(bf16x8 a, bf16x8 b, f32x4 c) { return __builtin_amdgcn_mfma_f32_16x16x32_bf16(a, b, c, 0, 0, 0); }
__device__ __forceinline__ f32x16 mfma32(bf16x8 a, bf16x8 b, f32x16 c) { return __builtin_amdgcn_mfma_f32_32x32x16_bf16(a, b, c, 0, 0, 0); }
__device__ __forceinline__ int crow(int r, int hi) { return (r & 3) + 8 * (r >> 2) + 4 * hi; }

__device__ __forceinline__ void transpose_item(const float* W, int ldw, int k0, int nsrc0, bf16_t* WT, int ldt, int ndst0, LAS float* scr, int lane) {
#pragma unroll 8
    for (int i = 0; i < 32; ++i) { const int kk = 2 * i + (lane >> 5); scr[kk * 33 + (lane & 31)] = W[(size_t)(k0 + kk) * ldw + nsrc0 + (lane & 31)]; }
    LDS_WAIT();
    const int c = lane & 7;
#pragma unroll
    for (int j = 0; j < 4; ++j) { const int n = (lane >> 3) + 8 * j; const LAS float* s = scr + (8 * c) * 33 + n;
        u32x4 o; o.x = pk_bf16(s[0 * 33], s[1 * 33]); o.y = pk_bf16(s[2 * 33], s[3 * 33]); o.z = pk_bf16(s[4 * 33], s[5 * 33]); o.w = pk_bf16(s[6 * 33], s[7 * 33]);
        *(u32x4*)(WT + (size_t)(ndst0 + n) * ldt + k0 + 8 * c) = o; }
    LDS_WAIT();
}

template <bool DO_LN, bool DO_GATES>
__device__ __forceinline__ void row_pass(const float* src, float* dstf, bf16_t* dstb, const float* g, const float* bt, const float* Wg, float* G, int gw, int ngw, int lane) {
    for (int m = gw; m < M; m += ngw) {
        const f32x4* xr = (const f32x4*)(src + (size_t)m * DM) + lane;
        f32x4 v[4];
#pragma unroll
        for (int j = 0; j < 4; ++j) v[j] = xr[64 * j];
        if (DO_LN) {
            float s = 0.f;
#pragma unroll
            for (int j = 0; j < 4; ++j) s += (v[j].x + v[j].y) + (v[j].z + v[j].w);
            const float mean = wave_sum(s) * (1.f / DM); float s2 = 0.f;
#pragma unroll
            for (int j = 0; j < 4; ++j) { v[j] = v[j] - mean; s2 += (v[j].x * v[j].x + v[j].y * v[j].y) + (v[j].z * v[j].z + v[j].w * v[j].w); }
            const float rstd = 1.f / sqrtf(wave_sum(s2) * (1.f / DM) + LN_EPS);
            f32x4* of = (f32x4*)(dstf + (size_t)m * DM) + lane;
#pragma unroll
            for (int j = 0; j < 4; ++j) { const f32x4 gg = ((const f32x4*)g)[lane + 64 * j], bb = ((const f32x4*)bt)[lane + 64 * j]; v[j] = v[j] * rstd * gg + bb; of[64 * j] = v[j]; }
        }
        u32x2* ob = (u32x2*)(dstb + (size_t)m * DM) + lane;
#pragma unroll
        for (int j = 0; j < 4; ++j) { u32x2 w; w.x = pk_bf16(v[j].x, v[j].y); w.y = pk_bf16(v[j].z, v[j].w); ob[64 * j] = w; }
        if (DO_GATES) {
            float keep = 0.f;
#pragma unroll
            for (int jg = 0; jg < 8; ++jg) { float s = 0.f;
#pragma unroll
                for (int j = 0; j < 4; ++j) { const f32x4 w = ((const f32x4*)(Wg + jg * DM))[lane + 64 * j]; s += (v[j].x * w.x + v[j].y * w.y) + (v[j].z * w.z + v[j].w * w.w); }
                s = wave_sum(s); if (lane == jg) keep = s; }
            if (lane < 8) G[(size_t)m * 8 + lane] = keep;
        }
    }
}

constexpr int AT_KB = 64 * 272, AT_VB = 64 * 256, AT_BUF = AT_KB + AT_VB;
__device__ __forceinline__ void attn_unit(LAS unsigned char* lds, const bf16_t* U, bf16_t* CAT, int b, int h, int qb, float lam, float out_scale, const float* gnorm, int tid) {
    asm volatile("" : "+v"(tid));
    const int lane = tid & 63, wid = __builtin_amdgcn_readfirstlane(tid >> 6), r32 = lane & 31, hi = lane >> 5;
    const int mp = wid >> 2, wq = wid & 3;
    const size_t rowbase = (size_t)b * SEQ;
    const int q0 = qb * 128 + wq * 32, qpos = q0 + r32;
    bf16x8 qf[4];
    { const bf16_t* qptr = U + (rowbase + qpos) * NU + UC_DQ + h * 128 + mp * 64 + hi * 8;
#pragma unroll
      for (int d0 = 0; d0 < 4; ++d0) qf[d0] = *(const bf16x8*)(qptr + 16 * d0); }
    const int nt = 2 * qb + 2;
    const bf16_t* kg = U + rowbase * NU + UC_DK + h * 128;
    const bf16_t* vg = U + rowbase * NU + UC_DV + h * 128;
    u32x4 kr[2], vr[2];
#define A_GLOAD(t) do { _Pragma("unroll") for (int i_ = 0; i_ < 2; ++i_) { const int c_ = tid + 512 * i_, row_ = c_ >> 4, ch_ = c_ & 15; \
        kr[i_] = *(const u32x4*)(kg + (size_t)(64 * (t) + row_) * NU + ch_ * 8); vr[i_] = *(const u32x4*)(vg + (size_t)(64 * (t) + row_) * NU + ch_ * 8); } } while (0)
#define A_LSTORE(bs) do { _Pragma("unroll") for (int i_ = 0; i_ < 2; ++i_) { const int c_ = tid + 512 * i_, row_ = c_ >> 4, ch_ = c_ & 15; \
        *(LAS u32x4*)(lds + (bs) * AT_BUF + row_ * 272 + ch_ * 16) = kr[i_]; \
        *(LAS u32x4*)(lds + (bs) * AT_BUF + AT_KB + ((row_ >> 3) * 4 + (ch_ >> 2)) * 512 + (row_ & 7) * 64 + (ch_ & 3) * 16) = vr[i_]; } } while (0)
    f32x16 o[4];
#pragma unroll
    for (int k = 0; k < 4; ++k)
#pragma unroll
        for (int r = 0; r < 16; ++r) o[k][r] = 0.f;
    float m_run = -INFINITY, l_run = 0.f;
    const float C = 0.125f * 1.4426950408889634f;
    const int vboff = (4 * hi + ((lane & 15) >> 2)) * 64 + ((lane >> 4) & 1) * 32 + (lane & 3) * 8;
    A_GLOAD(0); A_LSTORE(0); __syncthreads();
    for (int t = 0; t < nt; ++t) {
        if (t + 1 < nt) A_GLOAD(t + 1);
        if (64 * t <= q0 + 31) {
            const LAS unsigned char* Kb = lds + (t & 1) * AT_BUF; const LAS unsigned char* Vb = Kb + AT_KB;
            f32x16 s0, s1;
#pragma unroll
            for (int r = 0; r < 16; ++r) { s0[r] = 0.f; s1[r] = 0.f; }
#pragma unroll
            for (int d0 = 0; d0 < 4; ++d0) {
                const bf16x8 k0f = *(const LAS bf16x8*)(Kb + r32 * 272 + (mp * 64 + 16 * d0 + 8 * hi) * 2);
                const bf16x8 k1f = *(const LAS bf16x8*)(Kb + (r32 + 32) * 272 + (mp * 64 + 16 * d0 + 8 * hi) * 2);
                s0 = mfma32(k0f, qf[d0], s0); s1 = mfma32(k1f, qf[d0], s1);
            }
#pragma unroll
            for (int r = 0; r < 16; ++r) { s0[r] *= C; s1[r] *= C; }
            if (64 * t + 63 > q0) {
#pragma unroll
                for (int r = 0; r < 16; ++r) { const int key = 64 * t + crow(r, hi); if (key > qpos) s0[r] = -INFINITY; if (key + 32 > qpos) s1[r] = -INFINITY; }
            }
            float mx = fmaxf(s0[0], s1[0]);
#pragma unroll
            for (int r = 1; r < 16; ++r) mx = fmaxf(mx, fmaxf(s0[r], s1[r]));
            mx = fmaxf(mx, __shfl_xor(mx, 32));
            if (__any(mx > m_run + 8.f)) {
                const float mn = fmaxf(m_run, mx); const float f = exp2f(m_run - mn); m_run = mn; l_run *= f;
#pragma unroll
                for (int k = 0; k < 4; ++k)
#pragma unroll
                    for (int r = 0; r < 16; ++r) o[k][r] *= f;
            }
            float ls = 0.f;
#pragma unroll
            for (int r = 0; r < 16; ++r) { s0[r] = exp2f(s0[r] - m_run); s1[r] = exp2f(s1[r] - m_run); ls += s0[r] + s1[r]; }
            l_run += ls;
            bf16x8 pf[4];
            { u32x4 w;
              w.x = pk_bf16(s0[0], s0[1]); w.y = pk_bf16(s0[2], s0[3]); w.z = pk_bf16(s0[4], s0[5]); w.w = pk_bf16(s0[6], s0[7]); pf[0] = __builtin_bit_cast(bf16x8, w);
              w.x = pk_bf16(s0[8], s0[9]); w.y = pk_bf16(s0[10], s0[11]); w.z = pk_bf16(s0[12], s0[13]); w.w = pk_bf16(s0[14], s0[15]); pf[1] = __builtin_bit_cast(bf16x8, w);
              w.x = pk_bf16(s1[0], s1[1]); w.y = pk_bf16(s1[2], s1[3]); w.z = pk_bf16(s1[4], s1[5]); w.w = pk_bf16(s1[6], s1[7]); pf[2] = __builtin_bit_cast(bf16x8, w);
              w.x = pk_bf16(s1[8], s1[9]); w.y = pk_bf16(s1[10], s1[11]); w.z = pk_bf16(s1[12], s1[13]); w.w = pk_bf16(s1[14], s1[15]); pf[3] = __builtin_bit_cast(bf16x8, w); }
            const LAS unsigned char* vb = Vb + vboff;
#pragma unroll
            for (int blk = 0; blk < 4; ++blk)
#pragma unroll
                for (int ks = 0; ks < 4; ++ks) {
                    const s16x4 lo = __builtin_bit_cast(s16x4, __builtin_amdgcn_ds_read_tr16_b64_v4i16((LAS s16x4*)(vb + ks * 4096 + blk * 512)));
                    const s16x4 hh = __builtin_bit_cast(s16x4, __builtin_amdgcn_ds_read_tr16_b64_v4i16((LAS s16x4*)(vb + ks * 4096 + blk * 512 + 2048)));
                    const bf16x8 vf = {lo[0], lo[1], lo[2], lo[3], hh[0], hh[1], hh[2], hh[3]};
                    o[blk] = mfma32(vf, pf[ks], o[blk]);
                }
        }
        if (t + 1 < nt) A_LSTORE((t + 1) & 1);
        __syncthreads();
    }
#undef A_GLOAD
#undef A_LSTORE
    l_run += __shfl_xor(l_run, 32);
    const float inv = 1.f / l_run;
    LAS float* X = (LAS float*)lds + wq * 4096 + lane;
    if (mp == 1) {
        const float sc = inv * lam;
#pragma unroll
        for (int k = 0; k < 4; ++k)
#pragma unroll
            for (int r = 0; r < 16; ++r) X[(k * 16 + r) * 64] = o[k][r] * sc;
    }
    __syncthreads();
    if (mp == 0) {
        float ss = 0.f;
#pragma unroll
        for (int k = 0; k < 4; ++k)
#pragma unroll
            for (int r = 0; r < 16; ++r) { const float v = o[k][r] * inv - X[(k * 16 + r) * 64]; o[k][r] = v; ss += v * v; }
        ss += __shfl_xor(ss, 32);
        const float rn = out_scale / sqrtf(ss * (1.f / 128.f) + LN_EPS);
        bf16_t* orow = CAT + (rowbase + qpos) * DM + 512 + h * 128;
#pragma unroll
        for (int k = 0; k < 4; ++k)
#pragma unroll
            for (int r4 = 0; r4 < 4; ++r4) { const int dv = 32 * k + 8 * r4 + 4 * hi; const f32x4 g4 = *(const f32x4*)(gnorm + dv);
                u32x2 w; w.x = pk_bf16(o[k][4 * r4 + 0] * rn * g4.x, o[k][4 * r4 + 1] * rn * g4.y); w.y = pk_bf16(o[k][4 * r4 + 2] * rn * g4.z, o[k][4 * r4 + 3] * rn * g4.w);
                *(u32x2*)(orow + dv) = w; }
    }
    __syncthreads();
}

__device__ __forceinline__ void conv_unit(LAS unsigned char* lds, const bf16_t* U, bf16_t* CAT, int ct, const float* dw_w, const float* dw_b, const float* ln_g, const float* ln_b,
                                          const bf16_t* PwT, const float* pw_b, int tid) {
    asm volatile("" : "+v"(tid));
    const int lane = tid & 63, wid = __builtin_amdgcn_readfirstlane(tid >> 6);
    const int t0 = ct * 64, pos0 = t0 & (SEQ - 1);
    LAS float* Y = (LAS float*)lds;
    for (int id = tid; id < 94 * 32; id += NTHREADS) {
        const int r = id >> 5, c8 = id & 31; const int pos = pos0 - 30 + r;
        f32x4 y0 = {0.f, 0.f, 0.f, 0.f}, y1 = {0.f, 0.f, 0.f, 0.f};
        if (pos >= 0) {
            const bf16_t* up = U + (size_t)(t0 - 30 + r) * NU + 8 * c8;
            const u32x4 a = *(const u32x4*)(up + UC_CA), g = *(const u32x4*)(up + UC_CG);
            y0.x = bf_lo(a.x) * sigmoidf_(bf_lo(g.x)); y0.y = bf_hi(a.x) * sigmoidf_(bf_hi(g.x)); y0.z = bf_lo(a.y) * sigmoidf_(bf_lo(g.y)); y0.w = bf_hi(a.y) * sigmoidf_(bf_hi(g.y));
            y1.x = bf_lo(a.z) * sigmoidf_(bf_lo(g.z)); y1.y = bf_hi(a.z) * sigmoidf_(bf_hi(g.z)); y1.z = bf_lo(a.w) * sigmoidf_(bf_lo(g.w)); y1.w = bf_hi(a.w) * sigmoidf_(bf_hi(g.w));
        }
        *(LAS f32x4*)(Y + r * 256 + 8 * c8) = y0; *(LAS f32x4*)(Y + r * 256 + 8 * c8 + 4) = y1;
    }
    __syncthreads();
    f32x4 acc[8];
    { const f32x4 bias = *(const f32x4*)(dw_b + 4 * lane);
#pragma unroll
      for (int j = 0; j < 8; ++j) acc[j] = bias; }
#pragma unroll 1
    for (int tp = 0; tp < 31; ++tp) {
        const f32x4 w = *(const f32x4*)(dw_w + tp * 256 + 4 * lane);
        const LAS f32x4* yp = (const LAS f32x4*)(Y + (8 * wid + tp) * 256 + 4 * lane);
#pragma unroll
        for (int j = 0; j < 8; ++j) acc[j] += w * yp[j * 64];
    }
    { const f32x4 gg = *(const f32x4*)(ln_g + 4 * lane), bb = *(const f32x4*)(ln_b + 4 * lane);
#pragma unroll
      for (int j = 0; j < 8; ++j) {
        const float mean = wave_sum((acc[j].x + acc[j].y) + (acc[j].z + acc[j].w)) * (1.f / 256.f);
        f32x4 d = acc[j] - mean;
        const float var = wave_sum((d.x * d.x + d.y * d.y) + (d.z * d.z + d.w * d.w)) * (1.f / 256.f);
        const float rstd = 1.f / sqrtf(var + LN_EPS);
        d = d * rstd * gg + bb;
        d.x = d.x * sigmoidf_(d.x); d.y = d.y * sigmoidf_(d.y); d.z = d.z * sigmoidf_(d.z); d.w = d.w * sigmoidf_(d.w);
        acc[j] = d; } }
    __syncthreads();
    LAS unsigned char* At = lds;
#pragma unroll
    for (int j = 0; j < 8; ++j) { u32x2 w; w.x = pk_bf16(acc[j].x, acc[j].y); w.y = pk_bf16(acc[j].z, acc[j].w); *(LAS u32x2*)(At + (8 * wid + j) * 528 + lane * 8) = w; }
    __syncthreads();
    const int fr = lane & 15, fq = lane >> 4;
    f32x4 c[4][2];
#pragma unroll
    for (int mb = 0; mb < 4; ++mb)
#pragma unroll
        for (int nb = 0; nb < 2; ++nb) c[mb][nb] = (f32x4){0.f, 0.f, 0.f, 0.f};
#pragma unroll
    for (int ks = 0; ks < 8; ++ks) {
        bf16x8 bf[2], af[4];
#pragma unroll
        for (int nb = 0; nb < 2; ++nb) bf[nb] = *(const bf16x8*)(PwT + (size_t)(32 * wid + 16 * nb + fr) * 256 + 32 * ks + 8 * fq);
#pragma unroll
        for (int mb = 0; mb < 4; ++mb) af[mb] = *(const LAS bf16x8*)(At + (16 * mb + fr) * 528 + (32 * ks + 8 * fq) * 2);
#pragma unroll
        for (int mb = 0; mb < 4; ++mb)
#pragma unroll
            for (int nb = 0; nb < 2; ++nb) c[mb][nb] = mfma16(bf[nb], af[mb], c[mb][nb]);
    }
#pragma unroll
    for (int nb = 0; nb < 2; ++nb) { const int col = 32 * wid + 16 * nb + 4 * fq; const f32x4 bb = *(const f32x4*)(pw_b + col);
#pragma unroll
        for (int mb = 0; mb < 4; ++mb) { const f32x4 v = c[mb][nb] + bb; u32x2 w; w.x = pk_bf16(v.x, v.y); w.y = pk_bf16(v.z, v.w);
            *(u32x2*)(CAT + (size_t)(t0 + 16 * mb + fr) * DM + col) = w; } }
    __syncthreads();
}

#define ML_LAUNDER() int tid = tid_in; asm volatile("" : "+v"(tid)); const int lane = tid & 63, fr = lane & 15, fq = lane >> 4; (void)lane; (void)fr; (void)fq
__device__ __forceinline__ unsigned ld_agent(const unsigned* p) { return __hip_atomic_load(p, __ATOMIC_RELAXED, __HIP_MEMORY_SCOPE_AGENT); }
#define ML_SCAN_CORE() \
    const float lf0 = sLF[2 * lane], lf1 = sLF[2 * lane + 1], li0 = sLI[2 * lane], li1 = sLI[2 * lane + 1]; \
    const float c1 = lf0 + lf1; float tot = c1; \
    _Pragma("unroll") for (int o = 1; o < 64; o <<= 1) { const float t_ = __shfl_up(tot, o); if (lane >= o) tot += t_; } \
    const float excl = tot - c1; const float b0 = excl + lf0, b1 = excl + c1; \
    const float g = __shfl(tot, 63); \
    const float ct0 = li0 - b0, ct1 = li1 - b1; \
    const float pm1 = fmaxf(ct0, ct1); float sm = pm1; \
    _Pragma("unroll") for (int o = 1; o < 64; o <<= 1) { const float t_ = __shfl_up(sm, o); if (lane >= o) sm = fmaxf(sm, t_); } \
    float ex = __shfl_up(sm, 1); if (lane == 0) ex = -INFINITY; \
    const float pmax0 = fmaxf(ex, ct0), pmax1 = fmaxf(ex, pm1); \
    const float pall = __shfl(sm, 63); (void)pmax0; (void)pmax1; (void)b0; (void)b1

constexpr int S1_RAW = 0, S1_VT = 18944, S1_KPT = 40704, S1_SM = 58112;
__device__ __forceinline__ void ml_stage1(LAS unsigned char* lds, const bf16_t* U, const float* G, float* CL, float* MS, unsigned* cnt1, int bh, int ch, const float* b_ig, const float* b_fg,
                                          const float* cw, const float* cb, int tid_in) {
    const int wid = __builtin_amdgcn_readfirstlane(tid_in >> 6);
    const int b = bh >> 2, h = bh & 3, item = bh * 64 + ch;
    LAS float* SM = (LAS float*)(lds + S1_SM);
    LAS float* sLI = SM, *sLF = SM + 128, *sKS = SM + 256;
    const size_t rowbase = (size_t)b * SEQ, row0 = rowbase + (size_t)ch * 128;
    {   ML_LAUNDER();
        for (int i = tid; i < 16 * 136 / 2; i += NTHREADS) ((LAS unsigned*)(lds + S1_VT + 64 * 272))[i] = (i < 68) ? 0x3f803f80u : 0u;
        if (tid < 128) {
            const float gi = G[(row0 + tid) * 8 + h] + b_ig[h], gf = G[(row0 + tid) * 8 + 4 + h] + b_fg[h];
            sLI[tid] = gi; sLF[tid] = fminf(gf, 0.f) - log1pf(__expf(-fabsf(gf)));
        }
#pragma unroll
        for (int i = 0; i < 3; ++i) {
            const int id = tid + 512 * i;
            if (id < 131 * 8) {
                const int r = id >> 3, c = id & 7; const int pos = ch * 128 - 3 + r;
                u32x4 x = {0u, 0u, 0u, 0u};
                if (pos >= 0) x = *(const u32x4*)(U + (rowbase + pos) * NU + UC_MQK + 256 + 64 * h + 8 * c);
                *(LAS u32x4*)(lds + S1_RAW + r * 144 + c * 16) = x;
            }
        }
#pragma unroll
        for (int i = 0; i < 2; ++i) {
            const int id = tid + 512 * i, s = id & 127, vg8 = id >> 7;
            const u32x4 x = *(const u32x4*)(U + (row0 + s) * NU + UC_MV + 64 * h + 8 * vg8);
            LAS bf16_t* vt = (LAS bf16_t*)(lds + S1_VT) + (8 * vg8) * 136 + s;
            vt[0 * 136] = (bf16_t)(x.x & 0xffffu); vt[1 * 136] = (bf16_t)(x.x >> 16); vt[2 * 136] = (bf16_t)(x.y & 0xffffu); vt[3 * 136] = (bf16_t)(x.y >> 16);
            vt[4 * 136] = (bf16_t)(x.z & 0xffffu); vt[5 * 136] = (bf16_t)(x.z >> 16); vt[6 * 136] = (bf16_t)(x.w & 0xffffu); vt[7 * 136] = (bf16_t)(x.w >> 16);
        }
    }
    __syncthreads();
    if (wid == 0) {
        ML_LAUNDER();
        ML_SCAN_CORE();
        const float m_loc = g + pall;
        sKS[2 * lane] = __expf(g + ct0 - m_loc); sKS[2 * lane + 1] = __expf(g + ct1 - m_loc);
        if (lane == 0) { MS[item] = g; MS[1024 + item] = m_loc; }
    }
    __syncthreads();
    {   ML_LAUNDER();
#pragma unroll
        for (int i = 0; i < 2; ++i) {
            const int id = tid + 512 * i, s = id & 127, c = id >> 7;
            const int c0 = 256 + 64 * h + 8 * c;
            float y[8];
            { const f32x4 b0 = *(const f32x4*)(cb + c0), b1 = *(const f32x4*)(cb + c0 + 4); y[0] = b0.x; y[1] = b0.y; y[2] = b0.z; y[3] = b0.w; y[4] = b1.x; y[5] = b1.y; y[6] = b1.z; y[7] = b1.w; }
#pragma unroll
            for (int tp = 0; tp < 4; ++tp) {
                const u32x4 x = *(const LAS u32x4*)(lds + S1_RAW + (s + tp) * 144 + c * 16);
                const f32x4 w0 = *(const f32x4*)(cw + tp * 512 + c0), w1 = *(const f32x4*)(cw + tp * 512 + c0 + 4);
                y[0] += w0.x * bf_lo(x.x); y[1] += w0.y * bf_hi(x.x); y[2] += w0.z * bf_lo(x.y); y[3] += w0.w * bf_hi(x.y);
                y[4] += w1.x * bf_lo(x.z); y[5] += w1.y * bf_hi(x.z); y[6] += w1.z * bf_lo(x.w); y[7] += w1.w * bf_hi(x.w);
            }
            const float sc = 0.125f * sKS[s];
            LAS bf16_t* kp = (LAS bf16_t*)(lds + S1_KPT) + (8 * c) * 136 + s;
#pragma unroll
            for (int e = 0; e < 8; ++e) kp[e * 136] = f2bf(y[e] * sigmoidf_(y[e]) * sc);
        }
    }
    __syncthreads();
    {   ML_LAUNDER();
        float* clp = CL + (size_t)item * 5120;
#pragma unroll
        for (int k = 0; k < 3; ++k) {
            const int bi_ = wid + 8 * k;
            if (bi_ < 20) {
                const int rb = bi_ >> 2, kb = bi_ & 3;
                f32x4 c = {0.f, 0.f, 0.f, 0.f};
#pragma unroll
                for (int ks = 0; ks < 4; ++ks) {
                    const bf16x8 va = *(const LAS bf16x8*)(lds + S1_VT + (16 * rb + fr) * 272 + (32 * ks + 8 * fq) * 2);
                    const bf16x8 kf = *(const LAS bf16x8*)(lds + S1_KPT + (16 * kb + fr) * 272 + (32 * ks + 8 * fq) * 2);
                    c = mfma16(va, kf, c);
                }
                float* p = clp + (16 * rb + 4 * fq) * 64 + 16 * kb + fr;
                p[0] = c[0]; p[64] = c[1]; p[128] = c[2]; p[192] = c[3];
            }
        }
    }
    __builtin_amdgcn_fence(__ATOMIC_RELEASE, "agent");
    __syncthreads();
    if (tid_in == 0) __hip_atomic_fetch_add(cnt1, 1u, __ATOMIC_RELAXED, __HIP_MEMORY_SCOPE_AGENT);
}

__device__ __forceinline__ void ml_scan(const float* CL, bf16_t* CP, float* MS, const unsigned* cnt1, unsigned* flag2, int bh, int tid) {
    if (tid == 0) { while (ld_agent(cnt1) < 64u) __builtin_amdgcn_s_sleep(4); }
    __syncthreads();
    __builtin_amdgcn_fence(__ATOMIC_ACQUIRE, "agent");
    float c[9], nx[9];
#pragma unroll
    for (int i = 0; i < 9; ++i) c[i] = 0.f;
    float m = 0.f;
    const float* cl = CL + (size_t)(bh * 64) * 5120;
#pragma unroll
    for (int i = 0; i < 9; ++i) { const int idx = tid + 512 * i; nx[i] = (idx < 4160) ? cl[idx] : 0.f; }
    for (int ch = 0; ch < 64; ++ch) {
        const int item = bh * 64 + ch;
        const float g = MS[item], ml = MS[1024 + item];
        if (tid == 0) MS[2048 + item] = m;
        bf16_t* cp = CP + (size_t)item * 5120;
        float cur[9];
#pragma unroll
        for (int i = 0; i < 9; ++i) { const int idx = tid + 512 * i; if (idx < 4160) cp[idx] = f2bf(c[i]); cur[i] = nx[i]; }
        if (ch + 1 < 64) {
#pragma unroll
            for (int i = 0; i < 9; ++i) { const int idx = tid + 512 * i; nx[i] = (idx < 4160) ? cl[(size_t)(ch + 1) * 5120 + idx] : 0.f; }
        }
        const float m_new = fmaxf(g + m, ml), a = __expf(g + m - m_new), e = __expf(ml - m_new);
#pragma unroll
        for (int i = 0; i < 9; ++i) c[i] = a * c[i] + e * cur[i];
        m = m_new;
    }
    __builtin_amdgcn_fence(__ATOMIC_RELEASE, "agent");
    __syncthreads();
    if (tid == 0) __hip_atomic_store(flag2, 1u, __ATOMIC_RELAXED, __HIP_MEMORY_SCOPE_AGENT);
}

constexpr int S3_Q = 0, S3_K = 18432, S3_VT = 36864, S3_P = 58624, S3_CB = 94528, S3_SM = 106048;
__device__ __forceinline__ void ml_stage3(LAS unsigned char* lds, const bf16_t* U, const float* G, const bf16_t* CP, const float* MS, const unsigned* flag2, bf16_t* CAT, int bh, int ch,
                                          const float* b_ig, const float* b_fg, const float* cw, const float* cb, const float* ng, int tid_in) {
    const int wid = __builtin_amdgcn_readfirstlane(tid_in >> 6);
    const int b = bh >> 2, h = bh & 3, item = bh * 64 + ch;
    LAS float* SM = (LAS float*)(lds + S3_SM);
    LAS float* sLI = SM, *sLF = SM + 128, *sROW = SM + 256, *sCOL = SM + 384, *sAI = SM + 512, *sEN = SM + 640, *sRS = SM + 768;
    const size_t rowbase = (size_t)b * SEQ, row0 = rowbase + (size_t)ch * 128;
    if (tid_in == 0) { while (ld_agent(flag2) == 0u) __builtin_amdgcn_s_sleep(4); }
    __syncthreads();
    __builtin_amdgcn_fence(__ATOMIC_ACQUIRE, "agent");
    const float m_prev = MS[2048 + item];
    {   ML_LAUNDER();
        if (tid < 128) {
            const float gi = G[(row0 + tid) * 8 + h] + b_ig[h], gf = G[(row0 + tid) * 8 + 4 + h] + b_fg[h];
            sLI[tid] = gi; sLF[tid] = fminf(gf, 0.f) - log1pf(__expf(-fabsf(gf)));
        }
#pragma unroll
        for (int i = 0; i < 5; ++i) {
            const int id = tid + 512 * i;
            if (id < 131 * 16) {
                const int r = id >> 4, c = id & 15; const int pos = ch * 128 - 3 + r;
                u32x4 x = {0u, 0u, 0u, 0u};
                if (pos >= 0) x = *(const u32x4*)(U + (rowbase + pos) * NU + UC_MQK + ((c < 8) ? (64 * h + 8 * c) : (256 + 64 * h + 8 * (c - 8))));
                *(LAS u32x4*)(lds + S3_P + r * 272 + c * 16) = x;
            }
        }
#pragma unroll
        for (int i = 0; i < 2; ++i) {
            const int id = tid + 512 * i, s = id & 127, vg8 = id >> 7;
            const u32x4 x = *(const u32x4*)(U + (row0 + s) * NU + UC_MV + 64 * h + 8 * vg8);
            LAS bf16_t* vt = (LAS bf16_t*)(lds + S3_VT) + (8 * vg8) * 136 + s;
            vt[0 * 136] = (bf16_t)(x.x & 0xffffu); vt[1 * 136] = (bf16_t)(x.x >> 16); vt[2 * 136] = (bf16_t)(x.y & 0xffffu); vt[3 * 136] = (bf16_t)(x.y >> 16);
            vt[4 * 136] = (bf16_t)(x.z & 0xffffu); vt[5 * 136] = (bf16_t)(x.z >> 16); vt[6 * 136] = (bf16_t)(x.w & 0xffffu); vt[7 * 136] = (bf16_t)(x.w >> 16);
        }
#pragma unroll
        for (int i = 0; i < 2; ++i) {
            const int id = tid + 512 * i;
            if (id < 80 * 9) {
                const int r = id / 9, c = id - 9 * r;
                u32x4 x = {0u, 0u, 0u, 0u};
                if (r < 65 && c < 8) x = *(const u32x4*)(CP + (size_t)item * 5120 + r * 64 + 8 * c);
                *(LAS u32x4*)(lds + S3_CB + r * 144 + c * 16) = x;
            }
        }
    }
    __syncthreads();
    if (wid == 0) {
        ML_LAUNDER();
        ML_SCAN_CORE();
        (void)g; (void)pall;
        const float M0 = fmaxf(m_prev, pmax0), M1 = fmaxf(m_prev, pmax1);
        sROW[2 * lane] = -M0; sROW[2 * lane + 1] = -M1;
        sCOL[2 * lane] = ct0; sCOL[2 * lane + 1] = ct1;
        sAI[2 * lane] = __expf(m_prev - M0); sAI[2 * lane + 1] = __expf(m_prev - M1);
        sEN[2 * lane] = __expf(-(b0 + M0)); sEN[2 * lane + 1] = __expf(-(b1 + M1));
    }
    {   ML_LAUNDER();
#pragma unroll
        for (int i = 0; i < 4; ++i) {
            const int id = tid + 512 * i, j = id >> 4, c = id & 15;
            const int c0 = (c < 8) ? (64 * h + 8 * c) : (256 + 64 * h + 8 * (c - 8));
            float y[8];
            { const f32x4 b0 = *(const f32x4*)(cb + c0), b1 = *(const f32x4*)(cb + c0 + 4); y[0] = b0.x; y[1] = b0.y; y[2] = b0.z; y[3] = b0.w; y[4] = b1.x; y[5] = b1.y; y[6] = b1.z; y[7] = b1.w; }
#pragma unroll
            for (int tp = 0; tp < 4; ++tp) {
                const u32x4 x = *(const LAS u32x4*)(lds + S3_P + (j + tp) * 272 + c * 16);
                const f32x4 w0 = *(const f32x4*)(cw + tp * 512 + c0), w1 = *(const f32x4*)(cw + tp * 512 + c0 + 4);
                y[0] += w0.x * bf_lo(x.x); y[1] += w0.y * bf_hi(x.x); y[2] += w0.z * bf_lo(x.y); y[3] += w0.w * bf_hi(x.y);
                y[4] += w1.x * bf_lo(x.z); y[5] += w1.y * bf_hi(x.z); y[6] += w1.z * bf_lo(x.w); y[7] += w1.w * bf_hi(x.w);
            }
            const float sc = (c < 8) ? 1.f : 0.125f;
#pragma unroll
            for (int e = 0; e < 8; ++e) y[e] = y[e] * sigmoidf_(y[e]) * sc;
            u32x4 w; w.x = pk_bf16(y[0], y[1]); w.y = pk_bf16(y[2], y[3]); w.z = pk_bf16(y[4], y[5]); w.w = pk_bf16(y[6], y[7]);
            *(LAS u32x4*)(lds + ((c < 8) ? S3_Q : S3_K) + j * 144 + (c & 7) * 16) = w;
        }
    }
    __syncthreads();
    {   ML_LAUNDER();
        const int j = 16 * wid + fr;
        bf16x8 qfr[2];
#pragma unroll
        for (int ks = 0; ks < 2; ++ks) qfr[ks] = *(const LAS bf16x8*)(lds + S3_Q + j * 144 + (32 * ks + 8 * fq) * 2);
        const float rowt = sROW[j]; float rs = 0.f;
#pragma unroll
        for (int sb = 0; sb < 8; ++sb) {
            f32x4 sacc = {0.f, 0.f, 0.f, 0.f};
#pragma unroll
            for (int ks = 0; ks < 2; ++ks) { const bf16x8 kf = *(const LAS bf16x8*)(lds + S3_K + (16 * sb + fr) * 144 + (32 * ks + 8 * fq) * 2); sacc = mfma16(kf, qfr[ks], sacc); }
            const int s0 = 16 * sb + 4 * fq; float p[4];
#pragma unroll
            for (int e = 0; e < 4; ++e) { const int s = s0 + e; const float v = sacc[e] * __expf(rowt + sCOL[s]); p[e] = (s <= j) ? v : 0.f; rs += p[e]; }
            u32x2 w; w.x = pk_bf16(p[0], p[1]); w.y = pk_bf16(p[2], p[3]);
            *(LAS u32x2*)(lds + S3_P + j * 272 + s0 * 2) = w;
        }
        rs += __shfl_xor(rs, 16); rs += __shfl_xor(rs, 32);
        if (fq == 0) sRS[j] = rs;
    }
    LDS_WAIT();
    {   ML_LAUNDER();
        f32x4 acc[5];
#pragma unroll
        for (int vb = 0; vb < 5; ++vb) acc[vb] = (f32x4){0.f, 0.f, 0.f, 0.f};
#pragma unroll
        for (int ks = 0; ks < 2; ++ks) {
            const bf16x8 qa = *(const LAS bf16x8*)(lds + S3_Q + (16 * wid + fr) * 144 + (32 * ks + 8 * fq) * 2);
#pragma unroll
            for (int vb = 0; vb < 5; ++vb) { const bf16x8 cf = *(const LAS bf16x8*)(lds + S3_CB + (16 * vb + fr) * 144 + (32 * ks + 8 * fq) * 2); acc[vb] = mfma16(qa, cf, acc[vb]); }
        }
        const int jb = 16 * wid + 4 * fq;
        float ai[4], den[4];
#pragma unroll
        for (int e = 0; e < 4; ++e) ai[e] = sAI[jb + e];
#pragma unroll
        for (int vb = 0; vb < 5; ++vb)
#pragma unroll
            for (int e = 0; e < 4; ++e) acc[vb][e] *= ai[e];
#pragma unroll
        for (int e = 0; e < 4; ++e) { const float nq = __shfl(acc[4][e], lane & 48); den[e] = nq + sRS[jb + e]; den[e] = fmaxf(fabsf(den[e]), sEN[jb + e]); }
#pragma unroll
        for (int ks = 0; ks < 4; ++ks) {
            const bf16x8 pa = *(const LAS bf16x8*)(lds + S3_P + (16 * wid + fr) * 272 + (32 * ks + 8 * fq) * 2);
#pragma unroll
            for (int vb = 0; vb < 4; ++vb) { const bf16x8 vf = *(const LAS bf16x8*)(lds + S3_VT + (16 * vb + fr) * 272 + (32 * ks + 8 * fq) * 2); acc[vb] = mfma16(pa, vf, acc[vb]); }
        }
#pragma unroll
        for (int e = 0; e < 4; ++e) {
            const size_t row = row0 + jb + e;
            float hv[4]; float s = 0.f;
#pragma unroll
            for (int vb = 0; vb < 4; ++vb) { const float og = sigmoidf_(bf2f(U[row * NU + UC_MO + 64 * h + 16 * vb + fr])); hv[vb] = acc[vb][e] / den[e] * og; s += hv[vb]; }
            s += __shfl_xor(s, 1); s += __shfl_xor(s, 2); s += __shfl_xor(s, 4); s += __shfl_xor(s, 8);
            const float mean = s * (1.f / 64.f); float q = 0.f;
#pragma unroll
            for (int vb = 0; vb < 4; ++vb) { hv[vb] -= mean; q += hv[vb] * hv[vb]; }
            q += __shfl_xor(q, 1); q += __shfl_xor(q, 2); q += __shfl_xor(q, 4); q += __shfl_xor(q, 8);
            const float rstd = 1.f / sqrtf(q * (1.f / 64.f) + LN_EPS);
#pragma unroll
            for (int vb = 0; vb < 4; ++vb) CAT[row * DM + 256 + 64 * h + 16 * vb + fr] = f2bf(hv[vb] * rstd * ng[64 * h + 16 * vb + fr]);
        }
    }
    __syncthreads();
}

template <int l> __device__ __forceinline__ void run_layer(const Args& args, LAS unsigned char* lds, cg::grid_group& grid) {
    const int tid = threadIdx.x, lane = tid & 63, wid = __builtin_amdgcn_readfirstlane(tid >> 6);
    const int G = gridDim.x, bx = blockIdx.x;
    const int gw = bx * NWAVES + wid, ngw = G * NWAVES;
    unsigned char* ws = args.ws;
    unsigned* ctl = (unsigned*)(ws + WS_CTL);
    bf16_t* WinT = (bf16_t*)(ws + WS_WIN); bf16_t* WoT = (bf16_t*)(ws + WS_WOUT); bf16_t* WupT = (bf16_t*)(ws + WS_WUP); bf16_t* WdT = (bf16_t*)(ws + WS_WDN);
    bf16_t* PwT = (bf16_t*)(ws + WS_PW); float* Wg = (float*)(ws + WS_WG); float* Gt = (float*)(ws + WS_G);
    bf16_t* XB = (bf16_t*)(ws + WS_XB); bf16_t* CAT = (bf16_t*)(ws + WS_CAT); bf16_t* Ub = (bf16_t*)(ws + WS_U); bf16_t* HID = (bf16_t*)(ws + WS_U);
    float* out = args.out;
    const float* x_in = args.in[0];
        {
            pg8::Gemm g{XB, WinT + (size_t)l * NU * DM, M, NU, DM}; pg8::StaticOrder S; S.init(M, NU, G, bx);
            pg8::EpiBf16<0> E{Ub, NU};
            pg8::gemm_phase<pg8::EpiBf16<0>, pg8::StaticOrder, true, true>(lds, g, S, E);
        }
        grid.sync();
        {
            const float lam = ((const float*)ctl)[128 + l];
            const float linit = 0.8f - 0.6f * expf(-0.3f * (float)l);
            LAS int* sitem = (LAS int*)(lds + 140 * 1024);
            constexpr int N_S1 = 1024, N_SC = 16, N_AT = 1024, N_S3 = 1024, N_CV = 512;
            constexpr int E_S1 = N_S1, E_SC = E_S1 + N_SC, E_AT = E_SC + N_AT, E_S3 = E_AT + N_S3, E_CV = E_S3 + N_CV;
            float* CLb = (float*)(ws + WS_CL); bf16_t* CPb = (bf16_t*)(ws + WS_CP); float* MSb = (float*)(ws + WS_MS);
            unsigned* cnt1 = ctl + 1024 + l * 1024; unsigned* flag2 = ctl + 4096 + l * 1024;
#define FETCH_ITEM() do { if (tid == 0) sitem[0] = (int)atomicAdd(ctl + 64 * l, 1u); __syncthreads(); item = sitem[0]; __syncthreads(); } while (0)
            int item; FETCH_ITEM();
            while (item < E_S1) {
                const int bh = item & 15, ch = item >> 4;
                ml_stage1(lds, Ub, Gt, CLb, MSb, cnt1 + 64 * bh, bh, ch, args.in[2] + l * 4, args.in[3] + l * 4, args.in[10] + l * 2048, args.in[11] + l * 512, tid);
                FETCH_ITEM();
            }
            while (item < E_SC) {
                const int bh = item - E_S1;
                ml_scan(CLb, CPb, MSb, cnt1 + 64 * bh, flag2 + 64 * bh, bh, tid);
                FETCH_ITEM();
            }
            while (item < E_AT) {
                const int idx = item - E_SC; const int qb = 63 - (idx >> 4), bh = idx & 15;
                attn_unit(lds, Ub, CAT, bh >> 2, bh & 3, qb, lam, 1.f - linit, args.in[17] + l * 128, tid);
                FETCH_ITEM();
            }
            while (item < E_S3) {
                const int idx = item - E_AT; const int bh = idx & 15, ch = idx >> 4;
                ml_stage3(lds, Ub, Gt, CPb, MSb, flag2 + 64 * bh, CAT, bh, ch, args.in[2] + l * 4, args.in[3] + l * 4, args.in[10] + l * 2048, args.in[11] + l * 512, args.in[12] + l * 256, tid);
                FETCH_ITEM();
            }
            while (item < E_CV) {
                conv_unit(lds, Ub, CAT, item - E_S3, args.in[4] + l * 31 * 256, args.in[5] + l * 256, args.in[6] + l * 256, args.in[7] + l * 256, PwT + (size_t)l * 65536, args.in[9] + l * 256, tid);
                FETCH_ITEM();
            }
#undef FETCH_ITEM
        }
        grid.sync();
        {
            pg8::Gemm g{CAT, WoT + (size_t)l * DM * DM, M, DM, DM}; pg8::StaticOrder S; S.init(M, DM, G, bx);
            pg8::EpiRes E{(l == 0) ? x_in : (const float*)out, out, DM, ALPHA};
            pg8::gemm_phase<pg8::EpiRes, pg8::StaticOrder, true, true>(lds, g, S, E);
        }
        grid.sync();
        row_pass<true, false>(out, out, XB, args.in[19] + l * DM, args.in[20] + l * DM, nullptr, nullptr, gw, ngw, lane);
        grid.sync();
        {
            pg8::Gemm g{XB, WupT + (size_t)l * DFF * DM, M, DFF, DM}; pg8::StaticOrder S; S.init(M, DFF, G, bx);
            pg8::EpiBf16<2> E{HID, DFF};
            pg8::gemm_phase<pg8::EpiBf16<2>, pg8::StaticOrder, true, true>(lds, g, S, E);
        }
        grid.sync();
        {
            pg8::Gemm g{HID, WdT + (size_t)l * DM * DFF, M, DM, DFF}; pg8::StaticOrder S; S.init(M, DM, G, bx);
            pg8::EpiRes E{(const float*)out, out, DM, ALPHA};
            pg8::gemm_phase<pg8::EpiRes, pg8::StaticOrder, true, true>(lds, g, S, E);
        }
        grid.sync();
        if (l == 0) row_pass<true, true>(out, out, XB, args.in[23] + l * DM, args.in[24] + l * DM, Wg + 8 * DM, Gt, gw, ngw, lane);
        else row_pass<true, false>(out, out, XB, args.in[23] + l * DM, args.in[24] + l * DM, nullptr, nullptr, gw, ngw, lane);
        if (l == 0) grid.sync();
}

__global__ void __launch_bounds__(NTHREADS) hymba_fwd(Args args) {
    extern __shared__ __attribute__((aligned(16))) unsigned char lds_raw[];
    LAS unsigned char* lds = (LAS unsigned char*)lds_raw;
    cg::grid_group grid = cg::this_grid();
    const int tid = threadIdx.x, lane = tid & 63, wid = __builtin_amdgcn_readfirstlane(tid >> 6);
    const int G = gridDim.x, bx = blockIdx.x;
    const int gw = bx * NWAVES + wid, ngw = G * NWAVES;
    unsigned char* ws = args.ws;
    unsigned* ctl = (unsigned*)(ws + WS_CTL);
    bf16_t* WinT = (bf16_t*)(ws + WS_WIN); bf16_t* WoT = (bf16_t*)(ws + WS_WOUT); bf16_t* WupT = (bf16_t*)(ws + WS_WUP); bf16_t* WdT = (bf16_t*)(ws + WS_WDN);
    bf16_t* PwT = (bf16_t*)(ws + WS_PW); float* Wg = (float*)(ws + WS_WG); float* Gt = (float*)(ws + WS_G);
    bf16_t* XB = (bf16_t*)(ws + WS_XB); bf16_t* CAT = (bf16_t*)(ws + WS_CAT); bf16_t* Ub = (bf16_t*)(ws + WS_U); bf16_t* HID = (bf16_t*)(ws + WS_U);
    float* out = args.out;
    const float* x_in = args.in[0];

    {
        LAS float* scr = (LAS float*)(lds + wid * 16384);
        constexpr int I_IN = 16 * 96, I_O = 16 * 32, I_UP = 16 * 128, I_DN = 64 * 32, I_PW = 4 * 8, I_L = I_IN + I_O + I_UP + I_DN + I_PW;
        for (int it = gw; it < 2 * I_L; it += ngw) {
            const int l = it / I_L; int r = it % I_L;
            if (r < I_IN) { const int kb = r / 96, nb = r % 96, n0 = 32 * nb; transpose_item(args.in[1] + (size_t)l * DM * NIN, NIN, 64 * kb, n0 + (n0 >= 1536 ? 8 : 0), WinT + (size_t)l * NU * DM, DM, n0, scr, lane); continue; } r -= I_IN;
            if (r < I_O) { const int kb = r / 32, nb = r % 32; transpose_item(args.in[18] + (size_t)l * DM * DM, DM, 64 * kb, 32 * nb, WoT + (size_t)l * DM * DM, DM, 32 * nb, scr, lane); continue; } r -= I_O;
            if (r < I_UP) { const int kb = r / 128, nb = r % 128; transpose_item(args.in[21] + (size_t)l * DM * DFF, DFF, 64 * kb, 32 * nb, WupT + (size_t)l * DFF * DM, DM, 32 * nb, scr, lane); continue; } r -= I_UP;
            if (r < I_DN) { const int kb = r / 32, nb = r % 32; transpose_item(args.in[22] + (size_t)l * DFF * DM, DM, 64 * kb, 32 * nb, WdT + (size_t)l * DM * DFF, DFF, 32 * nb, scr, lane); continue; } r -= I_DN;
            { const int kb = r / 8, nb = r % 8; transpose_item(args.in[8] + (size_t)l * 65536, 256, 64 * kb, 32 * nb, PwT + (size_t)l * 65536, 256, 32 * nb, scr, lane); }
        }
        for (int i = bx * NTHREADS + tid; i < 2 * 8 * DM; i += G * NTHREADS) { const int l = i >> 13, jg = (i >> 10) & 7, k = i & 1023; Wg[i] = args.in[1][(size_t)l * DM * NIN + (size_t)k * NIN + 1536 + jg]; }
        if (bx == 0 && wid == 0) {
#pragma unroll
            for (int l = 0; l < 2; ++l) {
                const float s1 = wave_sum(args.in[13][l * 64 + lane] * args.in[14][l * 64 + lane]);
                const float s2 = wave_sum(args.in[15][l * 64 + lane] * args.in[16][l * 64 + lane]);
                const float linit = 0.8f - 0.6f * expf(-0.3f * (float)l);
                if (lane == 0) ((float*)ctl)[128 + l] = expf(s1) - expf(s2) + linit;
            }
        }
    }
    grid.sync();
    row_pass<false, true>(x_in, nullptr, XB, nullptr, nullptr, Wg, Gt, gw, ngw, lane);
    grid.sync();

    run_layer<0>(args, lds, grid);
    run_layer<1>(args, lds, grid);
}

extern "C" void kernel_launch(void* const* d_in, const int* in_sizes, int n_in, void* d_out, int out_size, void* d_ws, size_t ws_size, hipStream_t stream) {
    static int grid = 0;
    if (grid == 0) {
        if (n_in != 25 || out_size != M * DM || ws_size < WS_END) { fprintf(stderr, "kernel_launch: unexpected shapes (n_in %d out %d ws %zu)\n", n_in, out_size, ws_size); grid = -1; return; }
        int dev = 0, cus = 0, per_cu = 0;
        hipGetDevice(&dev); hipDeviceGetAttribute(&cus, hipDeviceAttributeMultiprocessorCount, dev);
        if (hipFuncSetAttribute((const void*)hymba_fwd, hipFuncAttributeMaxDynamicSharedMemorySize, LDS_BYTES) != hipSuccess) { fprintf(stderr, "kernel_launch: hipFuncSetAttribute failed\n"); grid = -1; return; }
        if (hipOccupancyMaxActiveBlocksPerMultiprocessor(&per_cu, (const void*)hymba_fwd, NTHREADS, LDS_BYTES) != hipSuccess || per_cu < 1) { fprintf(stderr, "kernel_launch: occupancy query failed (%d)\n", per_cu); per_cu = 1; }
        (void)hipGetLastError();
        grid = cus * per_cu;
        if (grid > 256) grid = 256;
    }
    if (grid < 0) return;
    hipMemsetAsync((char*)d_ws + WS_CTL, 0, CTL_BYTES, stream);
    Args a{};
    for (int i = 0; i < 25; ++i) a.in[i] = (const float*)d_in[i];
    a.out = (float*)d_out; a.ws = (unsigned char*)d_ws;
    void* kargs[] = {&a};
    hipError_t e = hipLaunchCooperativeKernel((const void*)hymba_fwd, dim3(grid), dim3(NTHREADS), kargs, LDS_BYTES, stream);
    if (e != hipSuccess) fprintf(stderr, "cooperative launch failed: %s (grid %d)\n", hipGetErrorString(e), grid);
}
```

```cpp
#include <hip/hip_runtime.h>
#include <hip/hip_cooperative_groups.h>
#include <cstdio>
#include <cstdint>
#include <cmath>
namespace cg = cooperative_groups;
namespace pg8 {
#define PG8_LAS __attribute__((address_space(3)))
typedef unsigned short bf16_t;
typedef short bf16x8 __attribute__((ext_vector_type(8)));
typedef float f32x4 __attribute__((ext_vector_type(4)));
typedef unsigned u32x4 __attribute__((ext_vector_type(4)));
constexpr int BM = 256, BK = 64, HALF = 128, HTB = HALF * BK * 2  , STAGE_BYTES = 8 * HTB, NXCD = 8, WGM = 8;

__host__ __device__ __forceinline__ int lds_byte(int r, int c) { const int st = (r >> 4) * 2 + (c >> 5), rr = r & 15, cc = c & 31, ob = rr * 64 + cc * 2; return st * 1024 + (ob ^ (((ob >> 9) & 1) << 5)); }
__host__ __device__ __forceinline__ void stage_rc(int b, int& R, int& C) { const int st = b / 1024, sb = b % 1024, swz = sb ^ (((sb >> 9) & 1) << 5); R = (st >> 1) * 16 + swz / 64; C = (st & 1) * 32 + (swz % 64) / 2; }
__host__ __device__ __forceinline__ int perm32(int rho) { const int n = rho >> 4, i = rho & 15; return 8 * (i >> 2) + 4 * n + (i & 3); }

struct Unit { int pm, pn; };
struct Gemm { const bf16_t* A; const bf16_t* Bt; int M, N, K; };

struct StaticOrder {
    int nM, nN, nwg, G, c;
    __host__ __device__ void init(int M, int N, int G_, int c_) { nM = M / BM; nN = N / BM; nwg = nM * nN; G = G_; c = c_; }
    __host__ __device__ bool next(int i, Unit& u) const {
        const long L = (long)i * G + c; if (L >= nwg) return false;
        int wgid = (int)L; { const int q = nwg / NXCD, r = nwg % NXCD, xcd = wgid % NXCD, off = wgid / NXCD; wgid = (xcd < r ? xcd * (q + 1) : r * (q + 1) + (xcd - r) * q) + off; }
        const int nig = WGM * nN, gid = wgid / nig, fm = gid * WGM, gsz = (nM - fm) < WGM ? (nM - fm) : WGM;
        u.pm = fm + ((wgid % nig) % gsz); u.pn = (wgid % nig) / gsz; return true;
    }
    __device__ __forceinline__ void a_ready(const Unit&) const {}
    __device__ __forceinline__ void done(const Unit&) const {}
};
__device__ __forceinline__ unsigned cvt_pk_bf16(float lo, float hi) { unsigned r; asm volatile("v_cvt_pk_bf16_f32 %0, %1, %2" : "=v"(r) : "v"(lo), "v"(hi)); return r; }
typedef float f32x2 __attribute__((ext_vector_type(2)));
template <int ACT  > struct EpiBf16 {
    static constexpr bool PERM = true, AFTER_DRAIN = false;
    bf16_t* O; int ldc;
    __device__ __forceinline__ void operator()(const f32x4 (&acc)[2][2][4][2], const Unit& u, int wr, int wc, int fr, int fq) const {
        const int row0 = u.pm * BM + wr * 64 + fr; const int col0 = u.pn * BM + wc * 32 + 8 * fq;
#pragma unroll
        for (int ai = 0; ai < 2; ++ai)
#pragma unroll
            for (int m = 0; m < 4; ++m) { bf16_t* rowp = O + (size_t)(row0 + ai * HALF + m * 16) * ldc + col0;
#pragma unroll
                for (int bj = 0; bj < 2; ++bj) { f32x4 v0 = acc[ai][bj][m][0], v1 = acc[ai][bj][m][1];
                    if (ACT == 2) {
#pragma unroll
                        for (int e = 0; e < 4; ++e) { const float a = fmaxf(v0[e], 0.f), b = fmaxf(v1[e], 0.f); v0[e] = a * a; v1[e] = b * b; } }
                    u32x4 w; w.x = cvt_pk_bf16(v0[0], v0[1]); w.y = cvt_pk_bf16(v0[2], v0[3]); w.z = cvt_pk_bf16(v1[0], v1[1]); w.w = cvt_pk_bf16(v1[2], v1[3]);
                    *(u32x4*)(rowp + bj * HALF) = w; } }
    }
};
struct EpiRes {
    static constexpr bool PERM = false, AFTER_DRAIN = false;
    const float* base; float* out; int ldc; float alpha;
    __device__ __forceinline__ void operator()(const f32x4 (&acc)[2][2][4][2], const Unit& u, int wr, int wc, int fr, int fq) const {
        const int col0 = u.pn * BM + wc * 32 + 4 * fq;
#pragma unroll
        for (int ai = 0; ai < 2; ++ai)
#pragma unroll
            for (int m = 0; m < 4; ++m) { const int r = u.pm * BM + ai * HALF + wr * 64 + m * 16 + fr; const size_t off = (size_t)r * ldc + col0;
#pragma unroll
                for (int bj = 0; bj < 2; ++bj)
#pragma unroll
                    for (int n = 0; n < 2; ++n) { const f32x4 bs = *(const f32x4*)(base + off + bj * HALF + n * 16); const f32x4 o = bs * alpha + acc[ai][bj][m][n];
                        *(f32x4*)(out + off + bj * HALF + n * 16) = o; }
                asm volatile("" ::: "memory"); }
    }
};
template <class Epi, class Sched, bool ALIGN_EPI = false, bool SP2 = false>
__device__ __forceinline__ void gemm_phase(PG8_LAS unsigned char* lds, const Gemm g, const Sched& S, const Epi& E) {
    const int tid = threadIdx.x, wid = __builtin_amdgcn_readfirstlane(tid >> 6), lane = tid & 63, wr = wid >> 2, wc = wid & 3, fr = lane & 15, fq = lane >> 4;
    const int K = g.K, nt = K / BK;
    unsigned voffA[2], voffB[2];
#pragma unroll
    for (int i = 0; i < 2; ++i) { int R, C; stage_rc(tid * 16 + i * 8192, R, C); const int Rb = Epi::PERM ? ((R & ~31) + perm32(R & 31)) : R;
        voffA[i] = (unsigned)(R * K + C) * 2u; voffB[i] = (unsigned)(Rb * K + C) * 2u; }
    const size_t kstep = (size_t)(BK * 2);
    const size_t hstep = (size_t)HALF * K * 2;
    const size_t tstep = 2 * hstep;
    const unsigned ldsw = (unsigned)wid * 1024u;
    const int aoff = lds_byte(wr * 64 + fr, fq * 8), boff = lds_byte(wc * 32 + fr, fq * 8);
#define PG8_SA(b, h) (((b) * 2 + (h)) * HTB)
#define PG8_SB(b, h) ((4 + (b) * 2 + (h)) * HTB)
#define PG8_STAGE(bufoff, gbase, voff) do { _Pragma("unroll") for (int _i = 0; _i < 2; ++_i) \
        __builtin_amdgcn_global_load_lds((const unsigned*)((const char*)(gbase) + (voff)[_i]), (PG8_LAS unsigned*)(lds + (bufoff) + ldsw + _i * 8192), 16, 0, 0); } while (0)
#define PG8_LDA(dst, b, h) do { _Pragma("unroll") for (int m = 0; m < 4; ++m) _Pragma("unroll") for (int k = 0; k < 2; ++k) dst[m][k] = *(const PG8_LAS bf16x8*)(lds + PG8_SA(b, h) + aoff + m * 2048 + k * 1024); } while (0)
#define PG8_LDB(dst, b, h) do { _Pragma("unroll") for (int n = 0; n < 2; ++n) _Pragma("unroll") for (int k = 0; k < 2; ++k) dst[n][k] = *(const PG8_LAS bf16x8*)(lds + PG8_SB(b, h) + boff + n * 2048 + k * 1024); } while (0)
#define PG8_MMA(ai, bj, At, Bt) do { __builtin_amdgcn_s_setprio(1); _Pragma("unroll") for (int m = 0; m < 4; ++m) _Pragma("unroll") for (int n = 0; n < 2; ++n) _Pragma("unroll") for (int k = 0; k < 2; ++k) \
        acc[ai][bj][m][n] = __builtin_amdgcn_mfma_f32_16x16x32_bf16(Bt[n][k], At[m][k], acc[ai][bj][m][n], 0, 0, 0); __builtin_amdgcn_s_setprio(0); } while (0)
#define PG8_WAIT_V(n) asm volatile("s_waitcnt vmcnt(" #n ")" ::: "memory")
#define PG8_WAIT_L(n) asm volatile("s_waitcnt lgkmcnt(" #n ")" ::: "memory")
#define PG8_BAR __builtin_amdgcn_s_barrier()
#define PG8_SCHED __builtin_amdgcn_sched_barrier(0)
    Unit cur, nxt; int ui = 0;
    if (!S.next(0, cur)) return;
    f32x4 acc[2][2][4][2];
#pragma unroll
    for (int a = 0; a < 2; ++a)
#pragma unroll
        for (int b = 0; b < 2; ++b)
#pragma unroll
            for (int m = 0; m < 4; ++m)
#pragma unroll
                for (int n = 0; n < 2; ++n) acc[a][b][m][n] = (f32x4){0.f, 0.f, 0.f, 0.f};
    bf16x8 At[4][2], B0[2][2], B1[2][2];
    const char* cA = (const char*)g.A + (size_t)cur.pm * tstep; const char* cB = (const char*)g.Bt + (size_t)cur.pn * tstep;
    S.a_ready(cur);
    if constexpr (SP2) {
        PG8_STAGE(PG8_SB(0, 0), cB, voffB); PG8_STAGE(PG8_SB(0, 1), cB + hstep, voffB); PG8_STAGE(PG8_SA(0, 0), cA, voffA); PG8_STAGE(PG8_SA(0, 1), cA + hstep, voffA);
        if (wr == 1) PG8_BAR;
        PG8_WAIT_V(2); PG8_BAR;
        PG8_STAGE(PG8_SB(1, 0), cB + kstep, voffB); PG8_STAGE(PG8_SA(1, 0), cA + kstep, voffA); PG8_STAGE(PG8_SB(1, 1), cB + hstep + kstep, voffB);
        PG8_WAIT_V(6); PG8_BAR;
    } else {
        PG8_STAGE(PG8_SB(0, 0), cB, voffB); PG8_STAGE(PG8_SA(0, 0), cA, voffA); PG8_STAGE(PG8_SB(0, 1), cB + hstep, voffB); PG8_STAGE(PG8_SA(0, 1), cA + hstep, voffA);
        if (wr == 1) PG8_BAR;
        PG8_WAIT_V(4); PG8_BAR;
        PG8_STAGE(PG8_SB(1, 0), cB + kstep, voffB); PG8_STAGE(PG8_SA(1, 0), cA + kstep, voffA); PG8_STAGE(PG8_SB(1, 1), cB + hstep + kstep, voffB);
        PG8_WAIT_V(6); PG8_BAR;
    }
    for (;;) {
        const bool has_next = S.next(ui + 1, nxt);
        const char* nA = has_next ? (const char*)g.A + (size_t)nxt.pm * tstep : cA; const char* nB = has_next ? (const char*)g.Bt + (size_t)nxt.pn * tstep : cB;
        for (int t = 0; t < nt; t += 2) {
            const bool last = (t == nt - 2);
            const char* a1 = cA + (size_t)(t + 1) * kstep;
            const char* a2 = last ? nA : cA + (size_t)(t + 2) * kstep; const char* b2 = last ? nB : cB + (size_t)(t + 2) * kstep;
            const char* a3 = a2 + kstep; const char* b3 = b2 + kstep;
            if (last && has_next) S.a_ready(nxt);
            if constexpr (SP2) {
            PG8_LDB(B0, 0, 0); PG8_LDB(B1, 0, 1); PG8_SCHED; PG8_LDA(At, 0, 0); PG8_STAGE(PG8_SA(1, 1), a1 + hstep, voffA);
            PG8_WAIT_V(8); PG8_WAIT_L(0); PG8_BAR; PG8_MMA(0, 0, At, B0); PG8_MMA(0, 1, At, B1); PG8_BAR; PG8_SCHED;
            PG8_LDA(At, 0, 1); PG8_STAGE(PG8_SB(0, 0), b2, voffB); PG8_STAGE(PG8_SB(0, 1), b2 + hstep, voffB); PG8_STAGE(PG8_SA(0, 0), a2, voffA);
            PG8_WAIT_V(8); PG8_WAIT_L(0); PG8_BAR; PG8_MMA(1, 0, At, B0); PG8_MMA(1, 1, At, B1); PG8_BAR; PG8_SCHED;
            PG8_LDB(B0, 1, 0); PG8_LDB(B1, 1, 1); PG8_SCHED; PG8_LDA(At, 1, 0); PG8_STAGE(PG8_SA(0, 1), a2 + hstep, voffA);
            PG8_WAIT_V(8); PG8_WAIT_L(0); PG8_BAR; PG8_MMA(0, 0, At, B0); PG8_MMA(0, 1, At, B1); PG8_BAR; PG8_SCHED;
            PG8_LDA(At, 1, 1); PG8_STAGE(PG8_SB(1, 0), b3, voffB); PG8_STAGE(PG8_SB(1, 1), b3 + hstep, voffB); PG8_STAGE(PG8_SA(1, 0), a3, voffA);
            PG8_WAIT_V(8); PG8_WAIT_L(0); PG8_BAR; PG8_MMA(1, 0, At, B0); PG8_MMA(1, 1, At, B1); PG8_BAR; PG8_SCHED;
            } else {
            PG8_LDB(B0, 0, 0); PG8_SCHED; PG8_LDA(At, 0, 0); PG8_STAGE(PG8_SA(1, 1), a1 + hstep, voffA);
            PG8_WAIT_L(8); PG8_BAR; PG8_WAIT_L(0); PG8_MMA(0, 0, At, B0); PG8_BAR; PG8_SCHED;
            PG8_LDB(B1, 0, 1); PG8_STAGE(PG8_SB(0, 0), b2, voffB);
            PG8_BAR; PG8_WAIT_L(0); PG8_MMA(0, 1, At, B1); PG8_BAR;
            PG8_LDA(At, 0, 1); PG8_STAGE(PG8_SA(0, 0), a2, voffA);
            PG8_BAR; PG8_WAIT_L(0); PG8_MMA(1, 0, At, B0); PG8_BAR; PG8_SCHED;
            PG8_STAGE(PG8_SB(0, 1), b2 + hstep, voffB);
            PG8_WAIT_V(6); PG8_BAR; PG8_MMA(1, 1, At, B1); PG8_BAR;
            PG8_LDB(B0, 1, 0); PG8_SCHED; PG8_LDA(At, 1, 0); PG8_STAGE(PG8_SA(0, 1), a2 + hstep, voffA);
            PG8_WAIT_L(8); PG8_BAR; PG8_WAIT_L(0); PG8_MMA(0, 0, At, B0); PG8_BAR; PG8_SCHED;
            PG8_LDB(B1, 1, 1); PG8_STAGE(PG8_SB(1, 0), b3, voffB);
            PG8_BAR; PG8_WAIT_L(0); PG8_MMA(0, 1, At, B1); PG8_BAR;
            PG8_LDA(At, 1, 1); PG8_STAGE(PG8_SA(1, 0), a3, voffA);
            PG8_BAR; PG8_WAIT_L(0); PG8_MMA(1, 0, At, B0); PG8_BAR; PG8_SCHED;
            PG8_STAGE(PG8_SB(1, 1), b3 + hstep, voffB);
            PG8_WAIT_V(6); PG8_BAR; PG8_MMA(1, 1, At, B1); PG8_BAR;
            }
        }
        if constexpr (ALIGN_EPI) { if (wr == 0) PG8_BAR; }
        if constexpr (!Epi::AFTER_DRAIN) { E(acc, cur, wr, wc, fr, fq); S.done(cur); }
        if (!has_next) break;
#pragma unroll
        for (int a = 0; a < 2; ++a)
#pragma unroll
            for (int b = 0; b < 2; ++b)
#pragma unroll
                for (int m = 0; m < 4; ++m)
#pragma unroll
                    for (int n = 0; n < 2; ++n) acc[a][b][m][n] = (f32x4){0.f, 0.f, 0.f, 0.f};
        cur = nxt; cA = nA; cB = nB; ++ui;
        if constexpr (ALIGN_EPI) { if (wr == 1) PG8_BAR; }
    }
    PG8_WAIT_V(0);
    if constexpr (!ALIGN_EPI) { if (wr == 0) PG8_BAR; }
    PG8_BAR;
    if constexpr (Epi::AFTER_DRAIN) { E.fused(acc, cur, wr, wc, fr, fq, lds, wid, lane); S.done(cur); }
#undef PG8_SA
#undef PG8_SB
#undef PG8_STAGE
#undef PG8_LDA
#undef PG8_LDB
#undef PG8_MMA
#undef PG8_WAIT_V
#undef PG8_WAIT_L
#undef PG8_BAR
#undef PG8_SCHED
}
}

#define LAS __attribute__((address_space(3)))
typedef unsigned short bf16_t;
typedef short bf16x8 __attribute__((ext_vector_type(8)));
typedef short s16x4 __attribute__((ext_vector_type(4)));
typedef float f32x4 __attribute__((ext_vector_type(4)));
typedef float f32x16 __attribute__((ext_vector_type(16)));
typedef unsigned u32x4 __attribute__((ext_vector_type(4)));
typedef unsigned u32x2 __attribute__((ext_vector_type(2)));

constexpr int BATCH = 4, SEQ = 8192, DM = 1024, M = BATCH * SEQ, NU = 3072, DFF = 4096, NIN = 3080;
constexpr float LN_EPS = 1e-5f;
constexpr float ALPHA = 1.4142135623730951f;
constexpr int NTHREADS = 512, NWAVES = 8;
constexpr int LDS_BYTES = 147456;

constexpr size_t MiB = 1u << 20;
constexpr size_t WS_CTL = 0, CTL_BYTES = 65536;
constexpr size_t WS_WIN = 2 * MiB, WS_WOUT = 14 * MiB, WS_WUP = 18 * MiB, WS_WDN = 34 * MiB, WS_PW = 50 * MiB, WS_WG = 50 * MiB + 512 * 1024;
constexpr size_t WS_G = 51 * MiB, WS_XB = 52 * MiB, WS_CAT = 116 * MiB, WS_U = 180 * MiB, WS_END = 436 * MiB;
constexpr size_t WS_CL = 372 * MiB, WS_CP = 392 * MiB, WS_MS = 402 * MiB;

constexpr int UC_CA = 0, UC_CG = 256, UC_MQK = 512, UC_MV = 1024, UC_MO = 1280, UC_DQ = 1536, UC_DK = 2048, UC_DV = 2560;

struct Args { const float* in[25]; float* out; unsigned char* ws; };

__device__ __forceinline__ float wave_sum(float v) {
#pragma unroll
    for (int o = 1; o < 64; o <<= 1) v += __shfl_xor(v, o);
    return v;
}
__device__ __forceinline__ unsigned pk_bf16(float lo, float hi) { typedef float f2 __attribute__((ext_vector_type(2))); typedef __bf16 b2 __attribute__((ext_vector_type(2))); f2 v = {lo, hi}; b2 b = __builtin_convertvector(v, b2); return __builtin_bit_cast(unsigned, b); }
__device__ __forceinline__ float bf_lo(unsigned u) { return __uint_as_float(u << 16); }
__device__ __forceinline__ float bf_hi(unsigned u) { return __uint_as_float(u & 0xffff0000u); }
__device__ __forceinline__ float bf2f(bf16_t h) { return __uint_as_float(((unsigned)h) << 16); }
__device__ __forceinline__ bf16_t f2bf(float f) { return (bf16_t)(pk_bf16(f, 0.f) & 0xffffu); }
__device__ __forceinline__ float sigmoidf_(float x) { return 1.f / (1.f + __expf(-x)); }
#define LDS_WAIT() asm volatile("s_waitcnt lgkmcnt(0)" ::: "memory")
__device__ __forceinline__ f32x4 mfma16(bf16x8 a, bf16x8 b, f32x4 c) { return __builtin_amdgcn_mfma_f32_16x16x32_bf16(a, b, c, 0, 0, 0); }
__device__ __forceinline__ f32x16 mfma32(bf16x8 a, bf16x8 b, f32x16 c) { return __builtin_amdgcn_mfma_f32_32x32x16_bf16(a, b, c, 0, 0, 0); }
__device__ __forceinline__ int crow(int r, int hi) { return (r & 3) + 8 * (r >> 2) + 4 * hi; }

__device__ __forceinline__ void transpose_item(const float* W, int ldw, int k0, int nsrc0, bf16_t* WT, int ldt, int ndst0, LAS float* scr, int lane) {
#pragma unroll 8
    for (int i = 0; i < 32; ++i) { const int kk = 2 * i + (lane >> 5); scr[kk * 33 + (lane & 31)] = W[(size_t)(k0 + kk) * ldw + nsrc0 + (lane & 31)]; }
    LDS_WAIT();
    const int c = lane & 7;
#pragma unroll
    for (int j = 0; j < 4; ++j) { const int n = (lane >> 3) + 8 * j; const LAS float* s = scr + (8 * c) * 33 + n;
        u32x4 o; o.x = pk_bf16(s[0 * 33], s[1 * 33]); o.y = pk_bf16(s[2 * 33], s[3 * 33]); o.z = pk_bf16(s[4 * 33], s[5 * 33]); o.w = pk_bf16(s[6 * 33], s[7 * 33]);
        *(u32x4*)(WT + (size_t)(ndst0 + n) * ldt + k0 + 8 * c) = o; }
    LDS_WAIT();
}

template <bool DO_LN, bool DO_GATES>
__device__ __forceinline__ void row_pass(const float* src, float* dstf, bf16_t* dstb, const float* g, const float* bt, const float* Wg, float* G, int gw, int ngw, int lane) {
    for (int m = gw; m < M; m += ngw) {
        const f32x4* xr = (const f32x4*)(src + (size_t)m * DM) + lane;
        f32x4 v[4];
#pragma unroll
        for (int j = 0; j < 4; ++j) v[j] = xr[64 * j];
        if (DO_LN) {
            float s = 0.f;
#pragma unroll
            for (int j = 0; j < 4; ++j) s += (v[j].x + v[j].y) + (v[j].z + v[j].w);
            const float mean = wave_sum(s) * (1.f / DM); float s2 = 0.f;
#pragma unroll
            for (int j = 0; j < 4; ++j) { v[j] = v[j] - mean; s2 += (v[j].x * v[j].x + v[j].y * v[j].y) + (v[j].z * v[j].z + v[j].w * v[j].w); }
            const float rstd = 1.f / sqrtf(wave_sum(s2) * (1.f / DM) + LN_EPS);
            f32x4* of = (f32x4*)(dstf + (size_t)m * DM) + lane;
#pragma unroll
            for (int j = 0; j < 4; ++j) { const f32x4 gg = ((const f32x4*)g)[lane + 64 * j], bb = ((const f32x4*)bt)[lane + 64 * j]; v[j] = v[j] * rstd * gg + bb; of[64 * j] = v[j]; }
        }
        u32x2* ob = (u32x2*)(dstb + (size_t)m * DM) + lane;
#pragma unroll
        for (int j = 0; j < 4; ++j) { u32x2 w; w.x = pk_bf16(v[j].x, v[j].y); w.y = pk_bf16(v[j].z, v[j].w); ob[64 * j] = w; }
        if (DO_GATES) {
            float keep = 0.f;
#pragma unroll
            for (int jg = 0; jg < 8; ++jg) { float s = 0.f;
#pragma unroll
                for (int j = 0; j < 4; ++j) { const f32x4 w = ((const f32x4*)(Wg + jg * DM))[lane + 64 * j]; s += (v[j].x * w.x + v[j].y * w.y) + (v[j].z * w.z + v[j].w * w.w); }
                s = wave_sum(s); if (lane == jg) keep = s; }
            if (lane < 8) G[(size_t)m * 8 + lane] = keep;
        }
    }
}

constexpr int AT_KB = 64 * 272, AT_VB = 64 * 256, AT_V0 = 2 * AT_KB;
__device__ __forceinline__ void attn_unit(LAS unsigned char* lds, const bf16_t* U, bf16_t* CAT, int b, int h, int qb, float lam, float out_scale, const float* gnorm, int tid) {
    asm volatile("" : "+v"(tid));
    const int lane = tid & 63, wid = __builtin_amdgcn_readfirstlane(tid >> 6), r32 = lane & 31, hi = lane >> 5;
    const int mp = wid >> 2, wq = wid & 3;
    const size_t rowbase = (size_t)b * SEQ;
    const int q0 = qb * 128 + wq * 32, qpos = q0 + r32;
    bf16x8 qf[4];
    { const bf16_t* qptr = U + (rowbase + qpos) * NU + UC_DQ + h * 128 + mp * 64 + hi * 8;
#pragma unroll
      for (int d0 = 0; d0 < 4; ++d0) qf[d0] = *(const bf16x8*)(qptr + 16 * d0); }
    const int nt = 2 * qb + 2;
    const bf16_t* kg = U + rowbase * NU + UC_DK + h * 128;
    const bf16_t* vg = U + rowbase * NU + UC_DV + h * 128;
    u32x4 kr[2], vr[2];
#define A_GLOADK(t) do { _Pragma("unroll") for (int i_ = 0; i_ < 2; ++i_) { const int c_ = tid + 512 * i_, row_ = c_ >> 4, ch_ = c_ & 15; kr[i_] = *(const u32x4*)(kg + (size_t)(64 * (t) + row_) * NU + ch_ * 8); } } while (0)
#define A_GLOADV(t) do { _Pragma("unroll") for (int i_ = 0; i_ < 2; ++i_) { const int c_ = tid + 512 * i_, row_ = c_ >> 4, ch_ = c_ & 15; vr[i_] = *(const u32x4*)(vg + (size_t)(64 * (t) + row_) * NU + ch_ * 8); } } while (0)
#define A_STOREK(bs) do { _Pragma("unroll") for (int i_ = 0; i_ < 2; ++i_) { const int c_ = tid + 512 * i_, row_ = c_ >> 4, ch_ = c_ & 15; *(LAS u32x4*)(lds + (bs) * AT_KB + row_ * 272 + ch_ * 16) = kr[i_]; } } while (0)
#define A_STOREV(bs) do { _Pragma("unroll") for (int i_ = 0; i_ < 2; ++i_) { const int c_ = tid + 512 * i_, row_ = c_ >> 4, ch_ = c_ & 15; \
        *(LAS u32x4*)(lds + AT_V0 + (bs) * AT_VB + ((row_ >> 3) * 4 + (ch_ >> 2)) * 512 + (row_ & 7) * 64 + (ch_ & 3) * 16) = vr[i_]; } } while (0)
#define A_QK(S0, S1, bs) do { const LAS unsigned char* Kb_ = lds + (bs) * AT_KB + r32 * 272 + (mp * 64 + 8 * hi) * 2; \
        _Pragma("unroll") for (int r_ = 0; r_ < 16; ++r_) { S0[r_] = 0.f; S1[r_] = 0.f; } \
        _Pragma("unroll") for (int d0 = 0; d0 < 4; ++d0) { const bf16x8 k0f = *(const LAS bf16x8*)(Kb_ + d0 * 32); const bf16x8 k1f = *(const LAS bf16x8*)(Kb_ + 32 * 272 + d0 * 32); \
            S0 = mfma32(k0f, qf[d0], S0); S1 = mfma32(k1f, qf[d0], S1); } } while (0)
    f32x16 o[4];
#pragma unroll
    for (int k = 0; k < 4; ++k)
#pragma unroll
        for (int r = 0; r < 16; ++r) o[k][r] = 0.f;
    float m_run = -INFINITY, l_run = 0.f;
    const float C = 0.125f * 1.4426950408889634f;
    const int vboff = (4 * hi + ((lane & 15) >> 2)) * 64 + ((lane >> 4) & 1) * 32 + (lane & 3) * 8;
    A_GLOADK(0); A_GLOADV(0); A_STOREK(0); A_STOREV(0); A_GLOADK(1); A_STOREK(1); __syncthreads();
    f32x16 sc0, sc1, sn0, sn1;
    A_QK(sc0, sc1, 0);
    for (int t = 0; t < nt; ++t) {
        if (t + 2 < nt) A_GLOADK(t + 2);
        if (t + 1 < nt) A_GLOADV(t + 1);
        const bool act_next = (t + 1 < nt) && (64 * (t + 1) <= q0 + 31);
        if (act_next) A_QK(sn0, sn1, (t + 1) & 1);
        if (64 * t <= q0 + 31) {
            if (64 * t + 63 > q0) {
#pragma unroll
                for (int r = 0; r < 16; ++r) { const int key = 64 * t + crow(r, hi); if (key > qpos) sc0[r] = -INFINITY; if (key + 32 > qpos) sc1[r] = -INFINITY; }
            }
            float mxa = __builtin_fmaxf(__builtin_fmaxf(sc0[0], sc0[1]), sc1[0]), mxb = __builtin_fmaxf(__builtin_fmaxf(sc0[2], sc0[3]), sc1[1]);
            mxa = __builtin_fmaxf(__builtin_fmaxf(mxa, sc1[2]), sc1[3]);
#pragma unroll
            for (int r = 4; r < 16; r += 4) { mxa = __builtin_fmaxf(__builtin_fmaxf(mxa, sc0[r]), sc0[r + 1]); mxb = __builtin_fmaxf(__builtin_fmaxf(mxb, sc0[r + 2]), sc0[r + 3]);
                mxa = __builtin_fmaxf(__builtin_fmaxf(mxa, sc1[r]), sc1[r + 1]); mxb = __builtin_fmaxf(__builtin_fmaxf(mxb, sc1[r + 2]), sc1[r + 3]); }
            float mx = __builtin_fmaxf(mxa, mxb) * C;
            mx = __builtin_fmaxf(mx, __shfl_xor(mx, 32));
            if (__any(mx > m_run + 8.f)) {
                const float mn = __builtin_fmaxf(m_run, mx); const float f = __builtin_amdgcn_exp2f(m_run - mn); m_run = mn; l_run *= f;
#pragma unroll
                for (int k = 0; k < 4; ++k)
#pragma unroll
                    for (int r = 0; r < 16; ++r) o[k][r] *= f;
            }
            const float nm = -m_run;
            float ls0 = 0.f, ls1 = 0.f;
#pragma unroll
            for (int r = 0; r < 16; ++r) { sc0[r] = __builtin_amdgcn_exp2f(__builtin_fmaf(sc0[r], C, nm)); sc1[r] = __builtin_amdgcn_exp2f(__builtin_fmaf(sc1[r], C, nm)); ls0 += sc0[r]; ls1 += sc1[r]; }
            l_run += ls0 + ls1;
            bf16x8 pf[4];
            { u32x4 w;
              w.x = pk_bf16(sc0[0], sc0[1]); w.y = pk_bf16(sc0[2], sc0[3]); w.z = pk_bf16(sc0[4], sc0[5]); w.w = pk_bf16(sc0[6], sc0[7]); pf[0] = __builtin_bit_cast(bf16x8, w);
              w.x = pk_bf16(sc0[8], sc0[9]); w.y = pk_bf16(sc0[10], sc0[11]); w.z = pk_bf16(sc0[12], sc0[13]); w.w = pk_bf16(sc0[14], sc0[15]); pf[1] = __builtin_bit_cast(bf16x8, w);
              w.x = pk_bf16(sc1[0], sc1[1]); w.y = pk_bf16(sc1[2], sc1[3]); w.z = pk_bf16(sc1[4], sc1[5]); w.w = pk_bf16(sc1[6], sc1[7]); pf[2] = __builtin_bit_cast(bf16x8, w);
              w.x = pk_bf16(sc1[8], sc1[9]); w.y = pk_bf16(sc1[10], sc1[11]); w.z = pk_bf16(sc1[12], sc1[13]); w.w = pk_bf16(sc1[14], sc1[15]); pf[3] = __builtin_bit_cast(bf16x8, w); }
            const LAS unsigned char* vb = lds + AT_V0 + (t & 1) * AT_VB + vboff;
#pragma unroll
            for (int ks = 0; ks < 4; ++ks)
#pragma unroll
                for (int blk = 0; blk < 4; ++blk) {
                    const s16x4 lo = __builtin_bit_cast(s16x4, __builtin_amdgcn_ds_read_tr16_b64_v4i16((LAS s16x4*)(vb + ks * 4096 + blk * 512)));
                    const s16x4 hh = __builtin_bit_cast(s16x4, __builtin_amdgcn_ds_read_tr16_b64_v4i16((LAS s16x4*)(vb + ks * 4096 + blk * 512 + 2048)));
                    const bf16x8 vf = {lo[0], lo[1], lo[2], lo[3], hh[0], hh[1], hh[2], hh[3]};
                    o[blk] = mfma32(vf, pf[ks], o[blk]);
                }
        }
        if (act_next) { sc0 = sn0; sc1 = sn1; }
        if (t + 2 < nt) A_STOREK(t & 1);
        if (t + 1 < nt) A_STOREV((t + 1) & 1);
        __syncthreads();
    }
#undef A_GLOADK
#undef A_GLOADV
#undef A_STOREK
#undef A_STOREV
#undef A_QK
    l_run += __shfl_xor(l_run, 32);
    const float inv = 1.f / l_run;
    LAS float* X = (LAS float*)lds + wq * 4096 + lane;
    if (mp == 1) {
        const float sc = inv * lam;
#pragma unroll
        for (int k = 0; k < 4; ++k)
#pragma unroll
            for (int r = 0; r < 16; ++r) X[(k * 16 + r) * 64] = o[k][r] * sc;
    }
    __syncthreads();
    if (mp == 0) {
        float ss = 0.f;
#pragma unroll
        for (int k = 0; k < 4; ++k)
#pragma unroll
            for (int r = 0; r < 16; ++r) { const float v = o[k][r] * inv - X[(k * 16 + r) * 64]; o[k][r] = v; ss += v * v; }
        ss += __shfl_xor(ss, 32);
        const float rn = out_scale / sqrtf(ss * (1.f / 128.f) + LN_EPS);
        bf16_t* orow = CAT + (rowbase + qpos) * DM + 512 + h * 128;
#pragma unroll
        for (int k = 0; k < 4; ++k)
#pragma unroll
            for (int r4 = 0; r4 < 4; ++r4) { const int dv = 32 * k + 8 * r4 + 4 * hi; const f32x4 g4 = *(const f32x4*)(gnorm + dv);
                u32x2 w; w.x = pk_bf16(o[k][4 * r4 + 0] * rn * g4.x, o[k][4 * r4 + 1] * rn * g4.y); w.y = pk_bf16(o[k][4 * r4 + 2] * rn * g4.z, o[k][4 * r4 + 3] * rn * g4.w);
                *(u32x2*)(orow + dv) = w; }
    }
    __syncthreads();
}

__device__ __forceinline__ void conv_unit(LAS unsigned char* lds, const bf16_t* U, bf16_t* CAT, int ct, const float* dw_w, const float* dw_b, const float* ln_g, const float* ln_b,
                                          const bf16_t* PwT, const float* pw_b, int tid) {
    asm volatile("" : "+v"(tid));
    const int lane = tid & 63, wid = __builtin_amdgcn_readfirstlane(tid >> 6);
    const int t0 = ct * 64, pos0 = t0 & (SEQ - 1);
    LAS float* Y = (LAS float*)lds;
    for (int id = tid; id < 94 * 32; id += NTHREADS) {
        const int r = id >> 5, c8 = id & 31; const int pos = pos0 - 30 + r;
        f32x4 y0 = {0.f, 0.f, 0.f, 0.f}, y1 = {0.f, 0.f, 0.f, 0.f};
        if (pos >= 0) {
            const bf16_t* up = U + (size_t)(t0 - 30 + r) * NU + 8 * c8;
            const u32x4 a = *(const u32x4*)(up + UC_CA), g = *(const u32x4*)(up + UC_CG);
            y0.x = bf_lo(a.x) * sigmoidf_(bf_lo(g.x)); y0.y = bf_hi(a.x) * sigmoidf_(bf_hi(g.x)); y0.z = bf_lo(a.y) * sigmoidf_(bf_lo(g.y)); y0.w = bf_hi(a.y) * sigmoidf_(bf_hi(g.y));
            y1.x = bf_lo(a.z) * sigmoidf_(bf_lo(g.z)); y1.y = bf_hi(a.z) * sigmoidf_(bf_hi(g.z)); y1.z = bf_lo(a.w) * sigmoidf_(bf_lo(g.w)); y1.w = bf_hi(a.w) * sigmoidf_(bf_hi(g.w));
        }
        *(LAS f32x4*)(Y + r * 256 + 8 * c8) = y0; *(LAS f32x4*)(Y + r * 256 + 8 * c8 + 4) = y1;
    }
    __syncthreads();
    f32x4 acc[8];
    { const f32x4 bias = *(const f32x4*)(dw_b + 4 * lane);
#pragma unroll
      for (int j = 0; j < 8; ++j) acc[j] = bias; }
#pragma unroll 1
    for (int tp = 0; tp < 31; ++tp) {
        const f32x4 w = *(const f32x4*)(dw_w + tp * 256 + 4 * lane);
        const LAS f32x4* yp = (const LAS f32x4*)(Y + (8 * wid + tp) * 256 + 4 * lane);
#pragma unroll
        for (int j = 0; j < 8; ++j) acc[j] += w * yp[j * 64];
    }
    { const f32x4 gg = *(const f32x4*)(ln_g + 4 * lane), bb = *(const f32x4*)(ln_b + 4 * lane);
#pragma unroll
      for (int j = 0; j < 8; ++j) {
        const float mean = wave_sum((acc[j].x + acc[j].y) + (acc[j].z + acc[j].w)) * (1.f / 256.f);
        f32x4 d = acc[j] - mean;
        const float var = wave_sum((d.x * d.x + d.y * d.y) + (d.z * d.z + d.w * d.w)) * (1.f / 256.f);
        const float rstd = 1.f / sqrtf(var + LN_EPS);
        d = d * rstd * gg + bb;
        d.x = d.x * sigmoidf_(d.x); d.y = d.y * sigmoidf_(d.y); d.z = d.z * sigmoidf_(d.z); d.w = d.w * sigmoidf_(d.w);
        acc[j] = d; } }
    __syncthreads();
    LAS unsigned char* At = lds;
#pragma unroll
    for (int j = 0; j < 8; ++j) { u32x2 w; w.x = pk_bf16(acc[j].x, acc[j].y); w.y = pk_bf16(acc[j].z, acc[j].w); *(LAS u32x2*)(At + (8 * wid + j) * 528 + lane * 8) = w; }
    __syncthreads();
    const int fr = lane & 15, fq = lane >> 4;
    f32x4 c[4][2];
#pragma unroll
    for (int mb = 0; mb < 4; ++mb)
#pragma unroll
        for (int nb = 0; nb < 2; ++nb) c[mb][nb] = (f32x4){0.f, 0.f, 0.f, 0.f};
#pragma unroll
    for (int ks = 0; ks < 8; ++ks) {
        bf16x8 bf[2], af[4];
#pragma unroll
        for (int nb = 0; nb < 2; ++nb) bf[nb] = *(const bf16x8*)(PwT + (size_t)(32 * wid + 16 * nb + fr) * 256 + 32 * ks + 8 * fq);
#pragma unroll
        for (int mb = 0; mb < 4; ++mb) af[mb] = *(const LAS bf16x8*)(At + (16 * mb + fr) * 528 + (32 * ks + 8 * fq) * 2);
#pragma unroll
        for (int mb = 0; mb < 4; ++mb)
#pragma unroll
            for (int nb = 0; nb < 2; ++nb) c[mb][nb] = mfma16(bf[nb], af[mb], c[mb][nb]);
    }
#pragma unroll
    for (int nb = 0; nb < 2; ++nb) { const int col = 32 * wid + 16 * nb + 4 * fq; const f32x4 bb = *(const f32x4*)(pw_b + col);
#pragma unroll
        for (int mb = 0; mb < 4; ++mb) { const f32x4 v = c[mb][nb] + bb; u32x2 w; w.x = pk_bf16(v.x, v.y); w.y = pk_bf16(v.z, v.w);
            *(u32x2*)(CAT + (size_t)(t0 + 16 * mb + fr) * DM + col) = w; } }
    __syncthreads();
}

#define ML_LAUNDER() int tid = tid_in; asm volatile("" : "+v"(tid)); const int lane = tid & 63, fr = lane & 15, fq = lane >> 4; (void)lane; (void)fr; (void)fq
__device__ __forceinline__ unsigned ld_agent(const unsigned* p) { return __hip_atomic_load(p, __ATOMIC_RELAXED, __HIP_MEMORY_SCOPE_AGENT); }
#define ML_SCAN_CORE() \
    const float lf0 = sLF[2 * lane], lf1 = sLF[2 * lane + 1], li0 = sLI[2 * lane], li1 = sLI[2 * lane + 1]; \
    const float c1 = lf0 + lf1; float tot = c1; \
    _Pragma("unroll") for (int o = 1; o < 64; o <<= 1) { const float t_ = __shfl_up(tot, o); if (lane >= o) tot += t_; } \
    const float excl = tot - c1; const float b0 = excl + lf0, b1 = excl + c1; \
    const float g = __shfl(tot, 63); \
    const float ct0 = li0 - b0, ct1 = li1 - b1; \
    const float pm1 = fmaxf(ct0, ct1); float sm = pm1; \
    _Pragma("unroll") for (int o = 1; o < 64; o <<= 1) { const float t_ = __shfl_up(sm, o); if (lane >= o) sm = fmaxf(sm, t_); } \
    float ex = __shfl_up(sm, 1); if (lane == 0) ex = -INFINITY; \
    const float pmax0 = fmaxf(ex, ct0), pmax1 = fmaxf(ex, pm1); \
    const float pall = __shfl(sm, 63); (void)pmax0; (void)pmax1; (void)b0; (void)b1

constexpr int S1_RAW = 0, S1_VT = 18944, S1_KPT = 40704, S1_SM = 58112;
__device__ __forceinline__ void ml_stage1(LAS unsigned char* lds, const bf16_t* U, const float* G, float* CL, float* MS, unsigned* cnt1, int bh, int ch, const float* b_ig, const float* b_fg,
                                          const float* cw, const float* cb, int tid_in) {
    const int wid = __builtin_amdgcn_readfirstlane(tid_in >> 6);
    const int b = bh >> 2, h = bh & 3, item = bh * 64 + ch;
    LAS float* SM = (LAS float*)(lds + S1_SM);
    LAS float* sLI = SM, *sLF = SM + 128, *sKS = SM + 256;
    const size_t rowbase = (size_t)b * SEQ, row0 = rowbase + (size_t)ch * 128;
    {   ML_LAUNDER();
        for (int i = tid; i < 16 * 136 / 2; i += NTHREADS) ((LAS unsigned*)(lds + S1_VT + 64 * 272))[i] = (i < 68) ? 0x3f803f80u : 0u;
        if (tid < 128) {
            const float gi = G[(row0 + tid) * 8 + h] + b_ig[h], gf = G[(row0 + tid) * 8 + 4 + h] + b_fg[h];
            sLI[tid] = gi; sLF[tid] = fminf(gf, 0.f) - log1pf(__expf(-fabsf(gf)));
        }
#pragma unroll
        for (int i = 0; i < 3; ++i) {
            const int id = tid + 512 * i;
            if (id < 131 * 8) {
                const int r = id >> 3, c = id & 7; const int pos = ch * 128 - 3 + r;
                u32x4 x = {0u, 0u, 0u, 0u};
                if (pos >= 0) x = *(const u32x4*)(U + (rowbase + pos) * NU + UC_MQK + 256 + 64 * h + 8 * c);
                *(LAS u32x4*)(lds + S1_RAW + r * 144 + c * 16) = x;
            }
        }
#pragma unroll
        for (int i = 0; i < 2; ++i) {
            const int id = tid + 512 * i, s = id & 127, vg8 = id >> 7;
            const u32x4 x = *(const u32x4*)(U + (row0 + s) * NU + UC_MV + 64 * h + 8 * vg8);
            LAS bf16_t* vt = (LAS bf16_t*)(lds + S1_VT) + (8 * vg8) * 136 + s;
            vt[0 * 136] = (bf16_t)(x.x & 0xffffu); vt[1 * 136] = (bf16_t)(x.x >> 16); vt[2 * 136] = (bf16_t)(x.y & 0xffffu); vt[3 * 136] = (bf16_t)(x.y >> 16);
            vt[4 * 136] = (bf16_t)(x.z & 0xffffu); vt[5 * 136] = (bf16_t)(x.z >> 16); vt[6 * 136] = (bf16_t)(x.w & 0xffffu); vt[7 * 136] = (bf16_t)(x.w >> 16);
        }
    }
    __syncthreads();
    if (wid == 0) {
        ML_LAUNDER();
        ML_SCAN_CORE();
        const float m_loc = g + pall;
        sKS[2 * lane] = __expf(g + ct0 - m_loc); sKS[2 * lane + 1] = __expf(g + ct1 - m_loc);
        if (lane == 0) { MS[item] = g; MS[1024 + item] = m_loc; }
    }
    __syncthreads();
    {   ML_LAUNDER();
#pragma unroll
        for (int i = 0; i < 2; ++i) {
            const int id = tid + 512 * i, s = id & 127, c = id >> 7;
            const int c0 = 256 + 64 * h + 8 * c;
            float y[8];
            { const f32x4 b0 = *(const f32x4*)(cb + c0), b1 = *(const f32x4*)(cb + c0 + 4); y[0] = b0.x; y[1] = b0.y; y[2] = b0.z; y[3] = b0.w; y[4] = b1.x; y[5] = b1.y; y[6] = b1.z; y[7] = b1.w; }
#pragma unroll
            for (int tp = 0; tp < 4; ++tp) {
                const u32x4 x = *(const LAS u32x4*)(lds + S1_RAW + (s + tp) * 144 + c * 16);
                const f32x4 w0 = *(const f32x4*)(cw + tp * 512 + c0), w1 = *(const f32x4*)(cw + tp * 512 + c0 + 4);
                y[0] += w0.x * bf_lo(x.x); y[1] += w0.y * bf_hi(x.x); y[2] += w0.z * bf_lo(x.y); y[3] += w0.w * bf_hi(x.y);
                y[4] += w1.x * bf_lo(x.z); y[5] += w1.y * bf_hi(x.z); y[6] += w1.z * bf_lo(x.w); y[7] += w1.w * bf_hi(x.w);
            }
            const float sc = 0.125f * sKS[s];
            LAS bf16_t* kp = (LAS bf16_t*)(lds + S1_KPT) + (8 * c) * 136 + s;
#pragma unroll
            for (int e = 0; e < 8; ++e) kp[e * 136] = f2bf(y[e] * sigmoidf_(y[e]) * sc);
        }
    }
    __syncthreads();
    {   ML_LAUNDER();
        float* clp = CL + (size_t)item * 5120;
#pragma unroll
        for (int k = 0; k < 3; ++k) {
            const int bi_ = wid + 8 * k;
            if (bi_ < 20) {
                const int rb = bi_ >> 2, kb = bi_ & 3;
                f32x4 c = {0.f, 0.f, 0.f, 0.f};
#pragma unroll
                for (int ks = 0; ks < 4; ++ks) {
                    const bf16x8 va = *(const LAS bf16x8*)(lds + S1_VT + (16 * rb + fr) * 272 + (32 * ks + 8 * fq) * 2);
                    const bf16x8 kf = *(const LAS bf16x8*)(lds + S1_KPT + (16 * kb + fr) * 272 + (32 * ks + 8 * fq) * 2);
                    c = mfma16(va, kf, c);
                }
                float* p = clp + (16 * rb + 4 * fq) * 64 + 16 * kb + fr;
                p[0] = c[0]; p[64] = c[1]; p[128] = c[2]; p[192] = c[3];
            }
        }
    }
    __builtin_amdgcn_fence(__ATOMIC_RELEASE, "agent");
    __syncthreads();
    if (tid_in == 0) __hip_atomic_fetch_add(cnt1, 1u, __ATOMIC_RELAXED, __HIP_MEMORY_SCOPE_AGENT);
}

__device__ __forceinline__ void ml_scan(const float* CL, bf16_t* CP, float* MS, const unsigned* cnt1, unsigned* flag2, int bh, int tid) {
    if (tid == 0) { while (ld_agent(cnt1) < 64u) __builtin_amdgcn_s_sleep(4); }
    __syncthreads();
    __builtin_amdgcn_fence(__ATOMIC_ACQUIRE, "agent");
    float c[9], nx[9];
#pragma unroll
    for (int i = 0; i < 9; ++i) c[i] = 0.f;
    float m = 0.f;
    const float* cl = CL + (size_t)(bh * 64) * 5120;
#pragma unroll
    for (int i = 0; i < 9; ++i) { const int idx = tid + 512 * i; nx[i] = (idx < 4160) ? cl[idx] : 0.f; }
    for (int ch = 0; ch < 64; ++ch) {
        const int item = bh * 64 + ch;
        const float g = MS[item], ml = MS[1024 + item];
        if (tid == 0) MS[2048 + item] = m;
        bf16_t* cp = CP + (size_t)item * 5120;
        float cur[9];
#pragma unroll
        for (int i = 0; i < 9; ++i) { const int idx = tid + 512 * i; if (idx < 4160) cp[idx] = f2bf(c[i]); cur[i] = nx[i]; }
        if (ch + 1 < 64) {
#pragma unroll
            for (int i = 0; i < 9; ++i) { const int idx = tid + 512 * i; nx[i] = (idx < 4160) ? cl[(size_t)(ch + 1) * 5120 + idx] : 0.f; }
        }
        const float m_new = fmaxf(g + m, ml), a = __expf(g + m - m_new), e = __expf(ml - m_new);
#pragma unroll
        for (int i = 0; i < 9; ++i) c[i] = a * c[i] + e * cur[i];
        m = m_new;
    }
    __builtin_amdgcn_fence(__ATOMIC_RELEASE, "agent");
    __syncthreads();
    if (tid == 0) __hip_atomic_store(flag2, 1u, __ATOMIC_RELAXED, __HIP_MEMORY_SCOPE_AGENT);
}

constexpr int S3_Q = 0, S3_K = 18432, S3_VT = 36864, S3_P = 58624, S3_CB = 94528, S3_SM = 106048;
__device__ __forceinline__ void ml_stage3(LAS unsigned char* lds, const bf16_t* U, const float* G, const bf16_t* CP, const float* MS, const unsigned* flag2, bf16_t* CAT, int bh, int ch,
                                          const float* b_ig, const float* b_fg, const float* cw, const float* cb, const float* ng, int tid_in) {
    const int wid = __builtin_amdgcn_readfirstlane(tid_in >> 6);
    const int b = bh >> 2, h = bh & 3, item = bh * 64 + ch;
    LAS float* SM = (LAS float*)(lds + S3_SM);
    LAS float* sLI = SM, *sLF = SM + 128, *sROW = SM + 256, *sCOL = SM + 384, *sAI = SM + 512, *sEN = SM + 640, *sRS = SM + 768;
    const size_t rowbase = (size_t)b * SEQ, row0 = rowbase + (size_t)ch * 128;
    if (tid_in == 0) { while (ld_agent(flag2) == 0u) __builtin_amdgcn_s_sleep(4); }
    __syncthreads();
    __builtin_amdgcn_fence(__ATOMIC_ACQUIRE, "agent");
    const float m_prev = MS[2048 + item];
    {   ML_LAUNDER();
        if (tid < 128) {
            const float gi = G[(row0 + tid) * 8 + h] + b_ig[h], gf = G[(row0 + tid) * 8 + 4 + h] + b_fg[h];
            sLI[tid] = gi; sLF[tid] = fminf(gf, 0.f) - log1pf(__expf(-fabsf(gf)));
        }
#pragma unroll
        for (int i = 0; i < 5; ++i) {
            const int id = tid + 512 * i;
            if (id < 131 * 16) {
                const int r = id >> 4, c = id & 15; const int pos = ch * 128 - 3 + r;
                u32x4 x = {0u, 0u, 0u, 0u};
                if (pos >= 0) x = *(const u32x4*)(U + (rowbase + pos) * NU + UC_MQK + ((c < 8) ? (64 * h + 8 * c) : (256 + 64 * h + 8 * (c - 8))));
                *(LAS u32x4*)(lds + S3_P + r * 272 + c * 16) = x;
            }
        }
#pragma unroll
        for (int i = 0; i < 2; ++i) {
            const int id = tid + 512 * i, s = id & 127, vg8 = id >> 7;
            const u32x4 x = *(const u32x4*)(U + (row0 + s) * NU + UC_MV + 64 * h + 8 * vg8);
            LAS bf16_t* vt = (LAS bf16_t*)(lds + S3_VT) + (8 * vg8) * 136 + s;
            vt[0 * 136] = (bf16_t)(x.x & 0xffffu); vt[1 * 136] = (bf16_t)(x.x >> 16); vt[2 * 136] = (bf16_t)(x.y & 0xffffu); vt[3 * 136] = (bf16_t)(x.y >> 16);
            vt[4 * 136] = (bf16_t)(x.z & 0xffffu); vt[5 * 136] = (bf16_t)(x.z >> 16); vt[6 * 136] = (bf16_t)(x.w & 0xffffu); vt[7 * 136] = (bf16_t)(x.w >> 16);
        }
#pragma unroll
        for (int i = 0; i < 2; ++i) {
            const int id = tid + 512 * i;
            if (id < 80 * 9) {
                const int r = id / 9, c = id - 9 * r;
                u32x4 x = {0u, 0u, 0u, 0u};
                if (r < 65 && c < 8) x = *(const u32x4*)(CP + (size_t)item * 5120 + r * 64 + 8 * c);
                *(LAS u32x4*)(lds + S3_CB + r * 144 + c * 16) = x;
            }
        }
    }
    __syncthreads();
    if (wid == 0) {
        ML_LAUNDER();
        ML_SCAN_CORE();
        (void)g; (void)pall;
        const float M0 = fmaxf(m_prev, pmax0), M1 = fmaxf(m_prev, pmax1);
        sROW[2 * lane] = -M0; sROW[2 * lane + 1] = -M1;
        sCOL[2 * lane] = ct0; sCOL[2 * lane + 1] = ct1;
        sAI[2 * lane] = __expf(m_prev - M0); sAI[2 * lane + 1] = __expf(m_prev - M1);
        sEN[2 * lane] = __expf(-(b0 + M0)); sEN[2 * lane + 1] = __expf(-(b1 + M1));
    }
    {   ML_LAUNDER();
#pragma unroll
        for (int i = 0; i < 4; ++i) {
            const int id = tid + 512 * i, j = id >> 4, c = id & 15;
            const int c0 = (c < 8) ? (64 * h + 8 * c) : (256 + 64 * h + 8 * (c - 8));
            float y[8];
            { const f32x4 b0 = *(const f32x4*)(cb + c0), b1 = *(const f32x4*)(cb + c0 + 4); y[0] = b0.x; y[1] = b0.y; y[2] = b0.z; y[3] = b0.w; y[4] = b1.x; y[5] = b1.y; y[6] = b1.z; y[7] = b1.w; }
#pragma unroll
            for (int tp = 0; tp < 4; ++tp) {
                const u32x4 x = *(const LAS u32x4*)(lds + S3_P + (j + tp) * 272 + c * 16);
                const f32x4 w0 = *(const f32x4*)(cw + tp * 512 + c0), w1 = *(const f32x4*)(cw + tp * 512 + c0 + 4);
                y[0] += w0.x * bf_lo(x.x); y[1] += w0.y * bf_hi(x.x); y[2] += w0.z * bf_lo(x.y); y[3] += w0.w * bf_hi(x.y);
                y[4] += w1.x * bf_lo(x.z); y[5] += w1.y * bf_hi(x.z); y[6] += w1.z * bf_lo(x.w); y[7] += w1.w * bf_hi(x.w);
            }
            const float sc = (c < 8) ? 1.f : 0.125f;
#pragma unroll
            for (int e = 0; e < 8; ++e) y[e] = y[e] * sigmoidf_(y[e]) * sc;
            u32x4 w; w.x = pk_bf16(y[0], y[1]); w.y = pk_bf16(y[2], y[3]); w.z = pk_bf16(y[4], y[5]); w.w = pk_bf16(y[6], y[7]);
            *(LAS u32x4*)(lds + ((c < 8) ? S3_Q : S3_K) + j * 144 + (c & 7) * 16) = w;
        }
    }
    __syncthreads();
    {   ML_LAUNDER();
        const int j = 16 * wid + fr;
        bf16x8 qfr[2];
#pragma unroll
        for (int ks = 0; ks < 2; ++ks) qfr[ks] = *(const LAS bf16x8*)(lds + S3_Q + j * 144 + (32 * ks + 8 * fq) * 2);
        const float rowt = sROW[j]; float rs = 0.f;
#pragma unroll
        for (int sb = 0; sb < 8; ++sb) {
            f32x4 sacc = {0.f, 0.f, 0.f, 0.f};
#pragma unroll
            for (int ks = 0; ks < 2; ++ks) { const bf16x8 kf = *(const LAS bf16x8*)(lds + S3_K + (16 * sb + fr) * 144 + (32 * ks + 8 * fq) * 2); sacc = mfma16(kf, qfr[ks], sacc); }
            const int s0 = 16 * sb + 4 * fq; float p[4];
#pragma unroll
            for (int e = 0; e < 4; ++e) { const int s = s0 + e; const float v = sacc[e] * __expf(rowt + sCOL[s]); p[e] = (s <= j) ? v : 0.f; rs += p[e]; }
            u32x2 w; w.x = pk_bf16(p[0], p[1]); w.y = pk_bf16(p[2], p[3]);
            *(LAS u32x2*)(lds + S3_P + j * 272 + s0 * 2) = w;
        }
        rs += __shfl_xor(rs, 16); rs += __shfl_xor(rs, 32);
        if (fq == 0) sRS[j] = rs;
    }
    LDS_WAIT();
    {   ML_LAUNDER();
        f32x4 acc[5];
#pragma unroll
        for (int vb = 0; vb < 5; ++vb) acc[vb] = (f32x4){0.f, 0.f, 0.f, 0.f};
#pragma unroll
        for (int ks = 0; ks < 2; ++ks) {
            const bf16x8 qa = *(const LAS bf16x8*)(lds + S3_Q + (16 * wid + fr) * 144 + (32 * ks + 8 * fq) * 2);
#pragma unroll
            for (int vb = 0; vb < 5; ++vb) { const bf16x8 cf = *(const LAS bf16x8*)(lds + S3_CB + (16 * vb + fr) * 144 + (32 * ks + 8 * fq) * 2); acc[vb] = mfma16(qa, cf, acc[vb]); }
        }
        const int jb = 16 * wid + 4 * fq;
        float ai[4], den[4];
#pragma unroll
        for (int e = 0; e < 4; ++e) ai[e] = sAI[jb + e];
#pragma unroll
        for (int vb = 0; vb < 5; ++vb)
#pragma unroll
            for (int e = 0; e < 4; ++e) acc[vb][e] *= ai[e];
#pragma unroll
        for (int e = 0; e < 4; ++e) { const float nq = __shfl(acc[4][e], lane & 48); den[e] = nq + sRS[jb + e]; den[e] = fmaxf(fabsf(den[e]), sEN[jb + e]); }
#pragma unroll
        for (int ks = 0; ks < 4; ++ks) {
            const bf16x8 pa = *(const LAS bf16x8*)(lds + S3_P + (16 * wid + fr) * 272 + (32 * ks + 8 * fq) * 2);
#pragma unroll
            for (int vb = 0; vb < 4; ++vb) { const bf16x8 vf = *(const LAS bf16x8*)(lds + S3_VT + (16 * vb + fr) * 272 + (32 * ks + 8 * fq) * 2); acc[vb] = mfma16(pa, vf, acc[vb]); }
        }
#pragma unroll
        for (int e = 0; e < 4; ++e) {
            const size_t row = row0 + jb + e;
            float hv[4]; float s = 0.f;
#pragma unroll
            for (int vb = 0; vb < 4; ++vb) { const float og = sigmoidf_(bf2f(U[row * NU + UC_MO + 64 * h + 16 * vb + fr])); hv[vb] = acc[vb][e] / den[e] * og; s += hv[vb]; }
            s += __shfl_xor(s, 1); s += __shfl_xor(s, 2); s += __shfl_xor(s, 4); s += __shfl_xor(s, 8);
            const float mean = s * (1.f / 64.f); float q = 0.f;
#pragma unroll
            for (int vb = 0; vb < 4; ++vb) { hv[vb] -= mean; q += hv[vb] * hv[vb]; }
            q += __shfl_xor(q, 1); q += __shfl_xor(q, 2); q += __shfl_xor(q, 4); q += __shfl_xor(q, 8);
            const float rstd = 1.f / sqrtf(q * (1.f / 64.f) + LN_EPS);
#pragma unroll
            for (int vb = 0; vb < 4; ++vb) CAT[row * DM + 256 + 64 * h + 16 * vb + fr] = f2bf(hv[vb] * rstd * ng[64 * h + 16 * vb + fr]);
        }
    }
    __syncthreads();
}

template <int l> __device__ __forceinline__ void run_layer(const Args& args, LAS unsigned char* lds, cg::grid_group& grid) {
    const int G = gridDim.x, bx = blockIdx.x;
#define PHASE_IDS() int tid = threadIdx.x; asm volatile("" : "+v"(tid)); const int lane = tid & 63, wid = __builtin_amdgcn_readfirstlane(tid >> 6); const int gw = bx * NWAVES + wid, ngw = G * NWAVES; (void)lane; (void)gw; (void)ngw
    unsigned char* ws = args.ws;
    unsigned* ctl = (unsigned*)(ws + WS_CTL);
    bf16_t* WinT = (bf16_t*)(ws + WS_WIN); bf16_t* WoT = (bf16_t*)(ws + WS_WOUT); bf16_t* WupT = (bf16_t*)(ws + WS_WUP); bf16_t* WdT = (bf16_t*)(ws + WS_WDN);
    bf16_t* PwT = (bf16_t*)(ws + WS_PW); float* Wg = (float*)(ws + WS_WG); float* Gt = (float*)(ws + WS_G);
    bf16_t* XB = (bf16_t*)(ws + WS_XB); bf16_t* CAT = (bf16_t*)(ws + WS_CAT); bf16_t* Ub = (bf16_t*)(ws + WS_U); bf16_t* HID = (bf16_t*)(ws + WS_U);
    float* out = args.out;
    const float* x_in = args.in[0];
        {
            pg8::Gemm g{XB, WinT + (size_t)l * NU * DM, M, NU, DM}; pg8::StaticOrder S; S.init(M, NU, G, bx);
            pg8::EpiBf16<0> E{Ub, NU};
            pg8::gemm_phase<pg8::EpiBf16<0>, pg8::StaticOrder, true, true>(lds, g, S, E);
        }
        grid.sync();
        {
            PHASE_IDS();
            const float lam = ((const float*)ctl)[128 + l];
            const float linit = 0.8f - 0.6f * expf(-0.3f * (float)l);
            LAS int* sitem = (LAS int*)(lds + 140 * 1024);
            constexpr int N_S1 = 1024, N_SC = 16, N_AT = 1024, N_S3 = 1024, N_CV = 512;
            constexpr int E_S1 = N_S1, E_SC = E_S1 + N_SC, E_AT = E_SC + N_AT, E_S3 = E_AT + N_S3, E_CV = E_S3 + N_CV;
            float* CLb = (float*)(ws + WS_CL); bf16_t* CPb = (bf16_t*)(ws + WS_CP); float* MSb = (float*)(ws + WS_MS);
            unsigned* cnt1 = ctl + 1024 + l * 1024; unsigned* flag2 = ctl + 4096 + l * 1024;
#define FETCH_ITEM() do { if (tid == 0) sitem[0] = (int)atomicAdd(ctl + 64 * l, 1u); __syncthreads(); item = sitem[0]; __syncthreads(); } while (0)
            int item; FETCH_ITEM();
            while (item < E_S1) {
                const int bh = item & 15, ch = item >> 4;
                ml_stage1(lds, Ub, Gt, CLb, MSb, cnt1 + 64 * bh, bh, ch, args.in[2] + l * 4, args.in[3] + l * 4, args.in[10] + l * 2048, args.in[11] + l * 512, tid);
                FETCH_ITEM();
            }
            while (item < E_SC) {
                const int bh = item - E_S1;
                ml_scan(CLb, CPb, MSb, cnt1 + 64 * bh, flag2 + 64 * bh, bh, tid);
                FETCH_ITEM();
            }
            while (item < E_AT) {
                const int idx = item - E_SC; const int qb = 63 - (idx >> 4), bh = idx & 15;
                attn_unit(lds, Ub, CAT, bh >> 2, bh & 3, qb, lam, 1.f - linit, args.in[17] + l * 128, tid);
                FETCH_ITEM();
            }
            while (item < E_S3) {
                const int idx = item - E_AT; const int bh = idx & 15, ch = idx >> 4;
                ml_stage3(lds, Ub, Gt, CPb, MSb, flag2 + 64 * bh, CAT, bh, ch, args.in[2] + l * 4, args.in[3] + l * 4, args.in[10] + l * 2048, args.in[11] + l * 512, args.in[12] + l * 256, tid);
                FETCH_ITEM();
            }
            while (item < E_CV) {
                conv_unit(lds, Ub, CAT, item - E_S3, args.in[4] + l * 31 * 256, args.in[5] + l * 256, args.in[6] + l * 256, args.in[7] + l * 256, PwT + (size_t)l * 65536, args.in[9] + l * 256, tid);
                FETCH_ITEM();
            }
#undef FETCH_ITEM
        }
        grid.sync();
        {
            pg8::Gemm g{CAT, WoT + (size_t)l * DM * DM, M, DM, DM}; pg8::StaticOrder S; S.init(M, DM, G, bx);
            pg8::EpiRes E{(l == 0) ? x_in : (const float*)out, out, DM, ALPHA};
            pg8::gemm_phase<pg8::EpiRes, pg8::StaticOrder, true, true>(lds, g, S, E);
        }
        grid.sync();
        { PHASE_IDS(); row_pass<true, false>(out, out, XB, args.in[19] + l * DM, args.in[20] + l * DM, nullptr, nullptr, gw, ngw, lane); }
        grid.sync();
        {
            pg8::Gemm g{XB, WupT + (size_t)l * DFF * DM, M, DFF, DM}; pg8::StaticOrder S; S.init(M, DFF, G, bx);
            pg8::EpiBf16<2> E{HID, DFF};
            pg8::gemm_phase<pg8::EpiBf16<2>, pg8::StaticOrder, true, true>(lds, g, S, E);
        }
        grid.sync();
        {
            pg8::Gemm g{HID, WdT + (size_t)l * DM * DFF, M, DM, DFF}; pg8::StaticOrder S; S.init(M, DM, G, bx);
            pg8::EpiRes E{(const float*)out, out, DM, ALPHA};
            pg8::gemm_phase<pg8::EpiRes, pg8::StaticOrder, true, true>(lds, g, S, E);
        }
        grid.sync();
        { PHASE_IDS();
          if (l == 0) row_pass<true, true>(out, out, XB, args.in[23] + l * DM, args.in[24] + l * DM, Wg + 8 * DM, Gt, gw, ngw, lane);
          else row_pass<true, false>(out, out, XB, args.in[23] + l * DM, args.in[24] + l * DM, nullptr, nullptr, gw, ngw, lane); }
        if (l == 0) grid.sync();
}
#undef PHASE_IDS

__global__ void __launch_bounds__(NTHREADS) hymba_fwd(Args args) {
    extern __shared__ __attribute__((aligned(16))) unsigned char lds_raw[];
    LAS unsigned char* lds = (LAS unsigned char*)lds_raw;
    cg::grid_group grid = cg::this_grid();
    const int tid = threadIdx.x, lane = tid & 63, wid = __builtin_amdgcn_readfirstlane(tid >> 6);
    const int G = gridDim.x, bx = blockIdx.x;
    const int gw = bx * NWAVES + wid, ngw = G * NWAVES;
    unsigned char* ws = args.ws;
    unsigned* ctl = (unsigned*)(ws + WS_CTL);
    bf16_t* WinT = (bf16_t*)(ws + WS_WIN); bf16_t* WoT = (bf16_t*)(ws + WS_WOUT); bf16_t* WupT = (bf16_t*)(ws + WS_WUP); bf16_t* WdT = (bf16_t*)(ws + WS_WDN);
    bf16_t* PwT = (bf16_t*)(ws + WS_PW); float* Wg = (float*)(ws + WS_WG); float* Gt = (float*)(ws + WS_G);
    bf16_t* XB = (bf16_t*)(ws + WS_XB); bf16_t* CAT = (bf16_t*)(ws + WS_CAT); bf16_t* Ub = (bf16_t*)(ws + WS_U); bf16_t* HID = (bf16_t*)(ws + WS_U);
    float* out = args.out;
    const float* x_in = args.in[0];

    {
        LAS float* scr = (LAS float*)(lds + wid * 16384);
        constexpr int I_IN = 16 * 96, I_O = 16 * 32, I_UP = 16 * 128, I_DN = 64 * 32, I_PW = 4 * 8, I_L = I_IN + I_O + I_UP + I_DN + I_PW;
        for (int it = gw; it < 2 * I_L; it += ngw) {
            const int l = it / I_L; int r = it % I_L;
            if (r < I_IN) { const int kb = r / 96, nb = r % 96, n0 = 32 * nb; transpose_item(args.in[1] + (size_t)l * DM * NIN, NIN, 64 * kb, n0 + (n0 >= 1536 ? 8 : 0), WinT + (size_t)l * NU * DM, DM, n0, scr, lane); continue; } r -= I_IN;
            if (r < I_O) { const int kb = r / 32, nb = r % 32; transpose_item(args.in[18] + (size_t)l * DM * DM, DM, 64 * kb, 32 * nb, WoT + (size_t)l * DM * DM, DM, 32 * nb, scr, lane); continue; } r -= I_O;
            if (r < I_UP) { const int kb = r / 128, nb = r % 128; transpose_item(args.in[21] + (size_t)l * DM * DFF, DFF, 64 * kb, 32 * nb, WupT + (size_t)l * DFF * DM, DM, 32 * nb, scr, lane); continue; } r -= I_UP;
            if (r < I_DN) { const int kb = r / 32, nb = r % 32; transpose_item(args.in[22] + (size_t)l * DFF * DM, DM, 64 * kb, 32 * nb, WdT + (size_t)l * DM * DFF, DFF, 32 * nb, scr, lane); continue; } r -= I_DN;
            { const int kb = r / 8, nb = r % 8; transpose_item(args.in[8] + (size_t)l * 65536, 256, 64 * kb, 32 * nb, PwT + (size_t)l * 65536, 256, 32 * nb, scr, lane); }
        }
        for (int i = bx * NTHREADS + tid; i < 2 * 8 * DM; i += G * NTHREADS) { const int l = i >> 13, jg = (i >> 10) & 7, k = i & 1023; Wg[i] = args.in[1][(size_t)l * DM * NIN + (size_t)k * NIN + 1536 + jg]; }
        if (bx == 0 && wid == 0) {
#pragma unroll
            for (int l = 0; l < 2; ++l) {
                const float s1 = wave_sum(args.in[13][l * 64 + lane] * args.in[14][l * 64 + lane]);
                const float s2 = wave_sum(args.in[15][l * 64 + lane] * args.in[16][l * 64 + lane]);
                const float linit = 0.8f - 0.6f * expf(-0.3f * (float)l);
                if (lane == 0) ((float*)ctl)[128 + l] = expf(s1) - expf(s2) + linit;
            }
        }
    }
    grid.sync();
    row_pass<false, true>(x_in, nullptr, XB, nullptr, nullptr, Wg, Gt, gw, ngw, lane);
    grid.sync();

    run_layer<0>(args, lds, grid);
    run_layer<1>(args, lds, grid);
}

extern "C" void kernel_launch(void* const* d_in, const int* in_sizes, int n_in, void* d_out, int out_size, void* d_ws, size_t ws_size, hipStream_t stream) {
    static int grid = 0;
    if (grid == 0) {
        if (n_in != 25 || out_size != M * DM || ws_size < WS_END) { fprintf(stderr, "kernel_launch: unexpected shapes (n_in %d out %d ws %zu)\n", n_in, out_size, ws_size); grid = -1; return; }
        int dev = 0, cus = 0, per_cu = 0;
        hipGetDevice(&dev); hipDeviceGetAttribute(&cus, hipDeviceAttributeMultiprocessorCount, dev);
        if (hipFuncSetAttribute((const void*)hymba_fwd, hipFuncAttributeMaxDynamicSharedMemorySize, LDS_BYTES) != hipSuccess) { fprintf(stderr, "kernel_launch: hipFuncSetAttribute failed\n"); grid = -1; return; }
        if (hipOccupancyMaxActiveBlocksPerMultiprocessor(&per_cu, (const void*)hymba_fwd, NTHREADS, LDS_BYTES) != hipSuccess || per_cu < 1) { fprintf(stderr, "kernel_launch: occupancy query failed (%d)\n", per_cu); per_cu = 1; }
        (void)hipGetLastError();
        grid = cus * per_cu;
        if (grid > 256) grid = 256;
    }
    if (grid < 0) return;
    hipMemsetAsync((char*)d_ws + WS_CTL, 0, CTL_BYTES, stream);
    Args a{};
    for (int i = 0; i < 25; ++i) a.in[i] = (const float*)d_in[i];
    a.out = (float*)d_out; a.ws = (unsigned char*)d_ws;
    void* kargs[] = {&a};
    hipError_t e = hipLaunchCooperativeKernel((const void*)hymba_fwd, dim3(grid), dim3(NTHREADS), kargs, LDS_BYTES, stream);
    if (e != hipSuccess) fprintf(stderr, "cooperative launch failed: %s (grid %d)\n", hipGetErrorString(e), grid);
}
```

```cpp
#include <hip/hip_runtime.h>
#include <hip/hip_cooperative_groups.h>
#include <cstdio>
#include <cstdint>
#include <cmath>
namespace cg = cooperative_groups;
namespace pg8 {
#define PG8_LAS __attribute__((address_space(3)))
typedef unsigned short bf16_t;
typedef short bf16x8 __attribute__((ext_vector_type(8)));
typedef float f32x4 __attribute__((ext_vector_type(4)));
typedef unsigned u32x4 __attribute__((ext_vector_type(4)));
constexpr int BM = 256, BK = 64, HALF = 128, HTB = HALF * BK * 2  , STAGE_BYTES = 8 * HTB, NXCD = 8, WGM = 8;

__host__ __device__ __forceinline__ int lds_byte(int r, int c) { const int st = (r >> 4) * 2 + (c >> 5), rr = r & 15, cc = c & 31, ob = rr * 64 + cc * 2; return st * 1024 + (ob ^ (((ob >> 9) & 1) << 5)); }
__host__ __device__ __forceinline__ void stage_rc(int b, int& R, int& C) { const int st = b / 1024, sb = b % 1024, swz = sb ^ (((sb >> 9) & 1) << 5); R = (st >> 1) * 16 + swz / 64; C = (st & 1) * 32 + (swz % 64) / 2; }
__host__ __device__ __forceinline__ int perm32(int rho) { const int n = rho >> 4, i = rho & 15; return 8 * (i >> 2) + 4 * n + (i & 3); }

struct Unit { int pm, pn; };
struct Gemm { const bf16_t* A; const bf16_t* Bt; int M, N, K; };

struct StaticOrder {
    int nM, nN, nwg, G, c;
    __host__ __device__ void init(int M, int N, int G_, int c_) { nM = M / BM; nN = N / BM; nwg = nM * nN; G = G_; c = c_; }
    __host__ __device__ bool next(int i, Unit& u) const {
        const long L = (long)i * G + c; if (L >= nwg) return false;
        int wgid = (int)L; { const int q = nwg / NXCD, r = nwg % NXCD, xcd = wgid % NXCD, off = wgid / NXCD; wgid = (xcd < r ? xcd * (q + 1) : r * (q + 1) + (xcd - r) * q) + off; }
        const int nig = WGM * nN, gid = wgid / nig, fm = gid * WGM, gsz = (nM - fm) < WGM ? (nM - fm) : WGM;
        u.pm = fm + ((wgid % nig) % gsz); u.pn = (wgid % nig) / gsz; return true;
    }
    __device__ __forceinline__ void a_ready(const Unit&) const {}
    __device__ __forceinline__ void done(const Unit&) const {}
};
__device__ __forceinline__ unsigned cvt_pk_bf16(float lo, float hi) { unsigned r; asm volatile("v_cvt_pk_bf16_f32 %0, %1, %2" : "=v"(r) : "v"(lo), "v"(hi)); return r; }
typedef float f32x2 __attribute__((ext_vector_type(2)));
template <int ACT  > struct EpiBf16 {
    static constexpr bool PERM = true, AFTER_DRAIN = false;
    bf16_t* O; int ldc;
    __device__ __forceinline__ void operator()(const f32x4 (&acc)[2][2][4][2], const Unit& u, int wr, int wc, int fr, int fq) const {
        const int row0 = u.pm * BM + wr * 64 + fr; const int col0 = u.pn * BM + wc * 32 + 8 * fq;
#pragma unroll
        for (int ai = 0; ai < 2; ++ai)
#pragma unroll
            for (int m = 0; m < 4; ++m) { bf16_t* rowp = O + (size_t)(row0 + ai * HALF + m * 16) * ldc + col0;
#pragma unroll
                for (int bj = 0; bj < 2; ++bj) { f32x4 v0 = acc[ai][bj][m][0], v1 = acc[ai][bj][m][1];
                    if (ACT == 2) {
#pragma unroll
                        for (int e = 0; e < 4; ++e) { const float a = fmaxf(v0[e], 0.f), b = fmaxf(v1[e], 0.f); v0[e] = a * a; v1[e] = b * b; } }
                    u32x4 w; w.x = cvt_pk_bf16(v0[0], v0[1]); w.y = cvt_pk_bf16(v0[2], v0[3]); w.z = cvt_pk_bf16(v1[0], v1[1]); w.w = cvt_pk_bf16(v1[2], v1[3]);
                    *(u32x4*)(rowp + bj * HALF) = w; } }
    }
};
struct EpiRes {
    static constexpr bool PERM = false, AFTER_DRAIN = false;
    const float* base; float* out; int ldc; float alpha;
    __device__ __forceinline__ void operator()(const f32x4 (&acc)[2][2][4][2], const Unit& u, int wr, int wc, int fr, int fq) const {
        const int col0 = u.pn * BM + wc * 32 + 4 * fq;
#pragma unroll
        for (int ai = 0; ai < 2; ++ai)
#pragma unroll
            for (int m = 0; m < 4; ++m) { const int r = u.pm * BM + ai * HALF + wr * 64 + m * 16 + fr; const size_t off = (size_t)r * ldc + col0;
#pragma unroll
                for (int bj = 0; bj < 2; ++bj)
#pragma unroll
                    for (int n = 0; n < 2; ++n) { const f32x4 bs = *(const f32x4*)(base + off + bj * HALF + n * 16); const f32x4 o = bs * alpha + acc[ai][bj][m][n];
                        *(f32x4*)(out + off + bj * HALF + n * 16) = o; }
                asm volatile("" ::: "memory"); }
    }
};
template <class Epi, class Sched, bool ALIGN_EPI = false, bool SP2 = false>
__device__ __forceinline__ void gemm_phase(PG8_LAS unsigned char* lds, const Gemm g, const Sched& S, const Epi& E) {
    const int tid = threadIdx.x, wid = __builtin_amdgcn_readfirstlane(tid >> 6), lane = tid & 63, wr = wid >> 2, wc = wid & 3, fr = lane & 15, fq = lane >> 4;
    const int K = g.K, nt = K / BK;
    unsigned voffA[2], voffB[2];
#pragma unroll
    for (int i = 0; i < 2; ++i) { int R, C; stage_rc(tid * 16 + i * 8192, R, C); const int Rb = Epi::PERM ? ((R & ~31) + perm32(R & 31)) : R;
        voffA[i] = (unsigned)(R * K + C) * 2u; voffB[i] = (unsigned)(Rb * K + C) * 2u; }
    const size_t kstep = (size_t)(BK * 2);
    const size_t hstep = (size_t)HALF * K * 2;
    const size_t tstep = 2 * hstep;
    const unsigned ldsw = (unsigned)wid * 1024u;
    const int aoff = lds_byte(wr * 64 + fr, fq * 8), boff = lds_byte(wc * 32 + fr, fq * 8);
#define PG8_SA(b, h) (((b) * 2 + (h)) * HTB)
#define PG8_SB(b, h) ((4 + (b) * 2 + (h)) * HTB)
#define PG8_STAGE(bufoff, gbase, voff) do { _Pragma("unroll") for (int _i = 0; _i < 2; ++_i) \
        __builtin_amdgcn_global_load_lds((const unsigned*)((const char*)(gbase) + (voff)[_i]), (PG8_LAS unsigned*)(lds + (bufoff) + ldsw + _i * 8192), 16, 0, 0); } while (0)
#define PG8_LDA(dst, b, h) do { _Pragma("unroll") for (int m = 0; m < 4; ++m) _Pragma("unroll") for (int k = 0; k < 2; ++k) dst[m][k] = *(const PG8_LAS bf16x8*)(lds + PG8_SA(b, h) + aoff + m * 2048 + k * 1024); } while (0)
#define PG8_LDB(dst, b, h) do { _Pragma("unroll") for (int n = 0; n < 2; ++n) _Pragma("unroll") for (int k = 0; k < 2; ++k) dst[n][k] = *(const PG8_LAS bf16x8*)(lds + PG8_SB(b, h) + boff + n * 2048 + k * 1024); } while (0)
#define PG8_MMA(ai, bj, At, Bt) do { __builtin_amdgcn_s_setprio(1); _Pragma("unroll") for (int m = 0; m < 4; ++m) _Pragma("unroll") for (int n = 0; n < 2; ++n) _Pragma("unroll") for (int k = 0; k < 2; ++k) \
        acc[ai][bj][m][n] = __builtin_amdgcn_mfma_f32_16x16x32_bf16(Bt[n][k], At[m][k], acc[ai][bj][m][n], 0, 0, 0); __builtin_amdgcn_s_setprio(0); } while (0)
#define PG8_WAIT_V(n) asm volatile("s_waitcnt vmcnt(" #n ")" ::: "memory")
#define PG8_WAIT_L(n) asm volatile("s_waitcnt lgkmcnt(" #n ")" ::: "memory")
#define PG8_BAR __builtin_amdgcn_s_barrier()
#define PG8_SCHED __builtin_amdgcn_sched_barrier(0)
    Unit cur, nxt; int ui = 0;
    if (!S.next(0, cur)) return;
    f32x4 acc[2][2][4][2];
#pragma unroll
    for (int a = 0; a < 2; ++a)
#pragma unroll
        for (int b = 0; b < 2; ++b)
#pragma unroll
            for (int m = 0; m < 4; ++m)
#pragma unroll
                for (int n = 0; n < 2; ++n) acc[a][b][m][n] = (f32x4){0.f, 0.f, 0.f, 0.f};
    bf16x8 At[4][2], B0[2][2], B1[2][2];
    const char* cA = (const char*)g.A + (size_t)cur.pm * tstep; const char* cB = (const char*)g.Bt + (size_t)cur.pn * tstep;
    S.a_ready(cur);
    if constexpr (SP2) {
        PG8_STAGE(PG8_SB(0, 0), cB, voffB); PG8_STAGE(PG8_SB(0, 1), cB + hstep, voffB); PG8_STAGE(PG8_SA(0, 0), cA, voffA); PG8_STAGE(PG8_SA(0, 1), cA + hstep, voffA);
        if (wr == 1) PG8_BAR;
        PG8_WAIT_V(2); PG8_BAR;
        PG8_STAGE(PG8_SB(1, 0), cB + kstep, voffB); PG8_STAGE(PG8_SA(1, 0), cA + kstep, voffA); PG8_STAGE(PG8_SB(1, 1), cB + hstep + kstep, voffB);
        PG8_WAIT_V(6); PG8_BAR;
    } else {
        PG8_STAGE(PG8_SB(0, 0), cB, voffB); PG8_STAGE(PG8_SA(0, 0), cA, voffA); PG8_STAGE(PG8_SB(0, 1), cB + hstep, voffB); PG8_STAGE(PG8_SA(0, 1), cA + hstep, voffA);
        if (wr == 1) PG8_BAR;
        PG8_WAIT_V(4); PG8_BAR;
        PG8_STAGE(PG8_SB(1, 0), cB + kstep, voffB); PG8_STAGE(PG8_SA(1, 0), cA + kstep, voffA); PG8_STAGE(PG8_SB(1, 1), cB + hstep + kstep, voffB);
        PG8_WAIT_V(6); PG8_BAR;
    }
    for (;;) {
        const bool has_next = S.next(ui + 1, nxt);
        const char* nA = has_next ? (const char*)g.A + (size_t)nxt.pm * tstep : cA; const char* nB = has_next ? (const char*)g.Bt + (size_t)nxt.pn * tstep : cB;
        for (int t = 0; t < nt; t += 2) {
            const bool last = (t == nt - 2);
            const char* a1 = cA + (size_t)(t + 1) * kstep;
            const char* a2 = last ? nA : cA + (size_t)(t + 2) * kstep; const char* b2 = last ? nB : cB + (size_t)(t + 2) * kstep;
            const char* a3 = a2 + kstep; const char* b3 = b2 + kstep;
            if (last && has_next) S.a_ready(nxt);
            if constexpr (SP2) {
            PG8_LDB(B0, 0, 0); PG8_LDB(B1, 0, 1); PG8_SCHED; PG8_LDA(At, 0, 0); PG8_STAGE(PG8_SA(1, 1), a1 + hstep, voffA);
            PG8_WAIT_V(8); PG8_WAIT_L(0); PG8_BAR; PG8_MMA(0, 0, At, B0); PG8_MMA(0, 1, At, B1); PG8_BAR; PG8_SCHED;
            PG8_LDA(At, 0, 1); PG8_STAGE(PG8_SB(0, 0), b2, voffB); PG8_STAGE(PG8_SB(0, 1), b2 + hstep, voffB); PG8_STAGE(PG8_SA(0, 0), a2, voffA);
            PG8_WAIT_V(8); PG8_WAIT_L(0); PG8_BAR; PG8_MMA(1, 0, At, B0); PG8_MMA(1, 1, At, B1); PG8_BAR; PG8_SCHED;
            PG8_LDB(B0, 1, 0); PG8_LDB(B1, 1, 1); PG8_SCHED; PG8_LDA(At, 1, 0); PG8_STAGE(PG8_SA(0, 1), a2 + hstep, voffA);
            PG8_WAIT_V(8); PG8_WAIT_L(0); PG8_BAR; PG8_MMA(0, 0, At, B0); PG8_MMA(0, 1, At, B1); PG8_BAR; PG8_SCHED;
            PG8_LDA(At, 1, 1); PG8_STAGE(PG8_SB(1, 0), b3, voffB); PG8_STAGE(PG8_SB(1, 1), b3 + hstep, voffB); PG8_STAGE(PG8_SA(1, 0), a3, voffA);
            PG8_WAIT_V(8); PG8_WAIT_L(0); PG8_BAR; PG8_MMA(1, 0, At, B0); PG8_MMA(1, 1, At, B1); PG8_BAR; PG8_SCHED;
            } else {
            PG8_LDB(B0, 0, 0); PG8_SCHED; PG8_LDA(At, 0, 0); PG8_STAGE(PG8_SA(1, 1), a1 + hstep, voffA);
            PG8_WAIT_L(8); PG8_BAR; PG8_WAIT_L(0); PG8_MMA(0, 0, At, B0); PG8_BAR; PG8_SCHED;
            PG8_LDB(B1, 0, 1); PG8_STAGE(PG8_SB(0, 0), b2, voffB);
            PG8_BAR; PG8_WAIT_L(0); PG8_MMA(0, 1, At, B1); PG8_BAR;
            PG8_LDA(At, 0, 1); PG8_STAGE(PG8_SA(0, 0), a2, voffA);
            PG8_BAR; PG8_WAIT_L(0); PG8_MMA(1, 0, At, B0); PG8_BAR; PG8_SCHED;
            PG8_STAGE(PG8_SB(0, 1), b2 + hstep, voffB);
            PG8_WAIT_V(6); PG8_BAR; PG8_MMA(1, 1, At, B1); PG8_BAR;
            PG8_LDB(B0, 1, 0); PG8_SCHED; PG8_LDA(At, 1, 0); PG8_STAGE(PG8_SA(0, 1), a2 + hstep, voffA);
            PG8_WAIT_L(8); PG8_BAR; PG8_WAIT_L(0); PG8_MMA(0, 0, At, B0); PG8_BAR; PG8_SCHED;
            PG8_LDB(B1, 1, 1); PG8_STAGE(PG8_SB(1, 0), b3, voffB);
            PG8_BAR; PG8_WAIT_L(0); PG8_MMA(0, 1, At, B1); PG8_BAR;
            PG8_LDA(At, 1, 1); PG8_STAGE(PG8_SA(1, 0), a3, voffA);
            PG8_BAR; PG8_WAIT_L(0); PG8_MMA(1, 0, At, B0); PG8_BAR; PG8_SCHED;
            PG8_STAGE(PG8_SB(1, 1), b3 + hstep, voffB);
            PG8_WAIT_V(6); PG8_BAR; PG8_MMA(1, 1, At, B1); PG8_BAR;
            }
        }
        if constexpr (ALIGN_EPI) { if (wr == 0) PG8_BAR; }
        if constexpr (!Epi::AFTER_DRAIN) { E(acc, cur, wr, wc, fr, fq); S.done(cur); }
        if (!has_next) break;
#pragma unroll
        for (int a = 0; a < 2; ++a)
#pragma unroll
            for (int b = 0; b < 2; ++b)
#pragma unroll
                for (int m = 0; m < 4; ++m)
#pragma unroll
                    for (int n = 0; n < 2; ++n) acc[a][b][m][n] = (f32x4){0.f, 0.f, 0.f, 0.f};
        cur = nxt; cA = nA; cB = nB; ++ui;
        if constexpr (ALIGN_EPI) { if (wr == 1) PG8_BAR; }
    }
    PG8_WAIT_V(0);
    if constexpr (!ALIGN_EPI) { if (wr == 0) PG8_BAR; }
    PG8_BAR;
    if constexpr (Epi::AFTER_DRAIN) { E.fused(acc, cur, wr, wc, fr, fq, lds, wid, lane); S.done(cur); }
#undef PG8_SA
#undef PG8_SB
#undef PG8_STAGE
#undef PG8_LDA
#undef PG8_LDB
#undef PG8_MMA
#undef PG8_WAIT_V
#undef PG8_WAIT_L
#undef PG8_BAR
#undef PG8_SCHED
}
}

#define LAS __attribute__((address_space(3)))
typedef unsigned short bf16_t;
typedef short bf16x8 __attribute__((ext_vector_type(8)));
typedef short s16x4 __attribute__((ext_vector_type(4)));
typedef float f32x4 __attribute__((ext_vector_type(4)));
typedef float f32x16 __attribute__((ext_vector_type(16)));
typedef unsigned u32x4 __attribute__((ext_vector_type(4)));
typedef unsigned u32x2 __attribute__((ext_vector_type(2)));

constexpr int BATCH = 4, SEQ = 8192, DM = 1024, M = BATCH * SEQ, NU = 3072, DFF = 4096, NIN = 3080;
constexpr float LN_EPS = 1e-5f;
constexpr float ALPHA = 1.4142135623730951f;
constexpr int NTHREADS = 512, NWAVES = 8;
constexpr int LDS_BYTES = 147456;

constexpr size_t MiB = 1u << 20;
constexpr size_t WS_CTL = 0, CTL_BYTES = 65536;
constexpr size_t WS_WIN = 2 * MiB, WS_WOUT = 14 * MiB, WS_WUP = 18 * MiB, WS_WDN = 34 * MiB, WS_PW = 50 * MiB, WS_WG = 50 * MiB + 512 * 1024;
constexpr size_t WS_G = 51 * MiB, WS_XB = 52 * MiB, WS_CAT = 116 * MiB, WS_U = 180 * MiB, WS_END = 436 * MiB;
constexpr size_t WS_CL = 372 * MiB, WS_CP = 392 * MiB, WS_MS = 402 * MiB;

constexpr int UC_CA = 0, UC_CG = 256, UC_MQK = 512, UC_MV = 1024, UC_MO = 1280, UC_DQ = 1536, UC_DK = 2048, UC_DV = 2560;

struct Args { const float* in[25]; float* out; unsigned char* ws; };

__device__ __forceinline__ float wave_sum(float v) {
#pragma unroll
    for (int o = 1; o < 64; o <<= 1) v += __shfl_xor(v, o);
    return v;
}
__device__ __forceinline__ unsigned pk_bf16(float lo, float hi) { typedef float f2 __attribute__((ext_vector_type(2))); typedef __bf16 b2 __attribute__((ext_vector_type(2))); f2 v = {lo, hi}; b2 b = __builtin_convertvector(v, b2); return __builtin_bit_cast(unsigned, b); }
__device__ __forceinline__ float bf_lo(unsigned u) { return __uint_as_float(u << 16); }
__device__ __forceinline__ float bf_hi(unsigned u) { return __uint_as_float(u & 0xffff0000u); }
__device__ __forceinline__ float bf2f(bf16_t h) { return __uint_as_float(((unsigned)h) << 16); }
__device__ __forceinline__ bf16_t f2bf(float f) { return (bf16_t)(pk_bf16(f, 0.f) & 0xffffu); }
__device__ __forceinline__ float sigmoidf_(float x) { return 1.f / (1.f + __expf(-x)); }
#define LDS_WAIT() asm volatile("s_waitcnt lgkmcnt(0)" ::: "memory")
__device__ __forceinline__ f32x4 mfma16(bf16x8 a, bf16x8 b, f32x4 c) { return __builtin_amdgcn_mfma_f32_16x16x32_bf16(a, b, c, 0, 0, 0); }
__device__ __forceinline__ f32x16 mfma32(bf16x8 a, bf16x8 b, f32x16 c) { return __builtin_amdgcn_mfma_f32_32x32x16_bf16(a, b, c, 0, 0, 0); }
__device__ __forceinline__ int crow(int r, int hi) { return (r & 3) + 8 * (r >> 2) + 4 * hi; }

typedef __attribute__((address_space(1))) unsigned gu32;
#define XB_TMO      128
#define XB_XCNT(j)  (256  + 64 * (j))
#define XB_XSUB(j)  (1280 + 64 * (j))
#define XB_XGEN(j)  (2304 + 64 * (j))
#define XB_TOP      3328
#define XB_TOPGEN   3392
#define XCD_BAR_WORDS 3456
#define XB_SPIN_CAP (1u << 18)

__device__ __forceinline__ unsigned xb_ld(unsigned* p)              { return __hip_atomic_load(p, __ATOMIC_RELAXED, __HIP_MEMORY_SCOPE_AGENT); }
__device__ __forceinline__ unsigned xb_add(unsigned* p, unsigned v) { return __hip_atomic_fetch_add(p, v, __ATOMIC_RELAXED, __HIP_MEMORY_SCOPE_AGENT); }
__device__ __forceinline__ unsigned xb_xcc_id() { return (unsigned)__builtin_amdgcn_s_getreg((3 << 11) | 20) & 0xFu; }
#define XB_SPIN(cond, bar) do { unsigned _sp = 0; while (cond) { __builtin_amdgcn_s_sleep(1); \
    if ((++_sp & 255u) == 0u) { if (xb_ld(&(bar)[XB_TMO])) break; if (_sp > XB_SPIN_CAP) { atomicAdd(&(bar)[XB_TMO], 1u); break; } } } } while (0)

struct XcdBarrier {
    unsigned* bar; unsigned x;
    volatile LAS unsigned* st;
};

__device__ __forceinline__ XcdBarrier xcd_barrier_post(unsigned* bar, volatile LAS unsigned* st) {
    XcdBarrier b; b.bar = bar; b.x = xb_xcc_id(); b.st = st;
    if (threadIdx.x == 0) (void)xb_add(&bar[XB_XCNT(b.x)], 1u);
    return b;
}
__device__ __forceinline__ void xcd_barrier_complete(unsigned* bar, unsigned x, unsigned& nloc, unsigned& nx) {
    const unsigned G = gridDim.x * gridDim.y * gridDim.z;
    unsigned sum, cnt, mine, sp = 0u;
    for (;;) {
        sum = 0u; cnt = 0u; mine = 0u;
#pragma unroll
        for (unsigned j = 0; j < 16; ++j) { const unsigned c = xb_ld(&bar[XB_XCNT(j)]); sum += c; cnt += (c > 0u) ? 1u : 0u; mine = (j == x) ? c : mine; }
        if (sum == G) break;
        __builtin_amdgcn_s_sleep(1);
        if ((++sp & 255u) == 0u) { if (xb_ld(&bar[XB_TMO])) break; if (sp > XB_SPIN_CAP) { atomicAdd(&bar[XB_TMO], 1u); break; } }
    }
    nloc = mine > 0u ? mine : 1u; nx = cnt > 0u ? cnt : 1u;
}

__device__ __forceinline__ void xcd_barrier(const XcdBarrier& b) {
    asm volatile("s_waitcnt vmcnt(0)" ::: "memory");
    __syncthreads();
    if (threadIdx.x == 0) {
        unsigned* bar = b.bar;
        __builtin_amdgcn_s_waitcnt(0);
        unsigned nloc = b.st[0], nx = b.st[1];
        if (nloc == 0u) { xcd_barrier_complete(bar, b.x, nloc, nx); b.st[0] = nloc; b.st[1] = nx; }
        const unsigned old = xb_add(&bar[XB_XSUB(b.x)], 1u);
        const unsigned gen = old / nloc;
        if (old + 1u == (gen + 1u) * nloc) {
            __builtin_amdgcn_fence(__ATOMIC_RELEASE, "agent");
            asm volatile("s_waitcnt vmcnt(0)" ::: "memory");
            const unsigned og = xb_add(&bar[XB_TOP], 1u);
            const unsigned tg = og / nx;
            if (og + 1u == (tg + 1u) * nx) xb_add(&bar[XB_TOPGEN], 1u);
            else XB_SPIN(xb_ld(&bar[XB_TOPGEN]) == tg, bar);
            __builtin_amdgcn_fence(__ATOMIC_ACQUIRE, "agent");
            xb_add(&bar[XB_XGEN(b.x)], 1u);
            asm volatile("s_waitcnt vmcnt(0)" ::: "memory");
        } else {
            XB_SPIN(xb_ld(&bar[XB_XGEN(b.x)]) == gen, bar);
            __builtin_amdgcn_fence(__ATOMIC_ACQUIRE, "agent");
            asm volatile("s_waitcnt vmcnt(0)" ::: "memory");
        }
    }
    __syncthreads();
}

__device__ __forceinline__ void transpose_item(const float* W, int ldw, int k0, int nsrc0, bf16_t* WT, int ldt, int ndst0, LAS float* scr, int lane) {
#pragma unroll 8
    for (int i = 0; i < 32; ++i) { const int kk = 2 * i + (lane >> 5); scr[kk * 33 + (lane & 31)] = W[(size_t)(k0 + kk) * ldw + nsrc0 + (lane & 31)]; }
    LDS_WAIT();
    const int c = lane & 7;
#pragma unroll
    for (int j = 0; j < 4; ++j) { const int n = (lane >> 3) + 8 * j; const LAS float* s = scr + (8 * c) * 33 + n;
        u32x4 o; o.x = pk_bf16(s[0 * 33], s[1 * 33]); o.y = pk_bf16(s[2 * 33], s[3 * 33]); o.z = pk_bf16(s[4 * 33], s[5 * 33]); o.w = pk_bf16(s[6 * 33], s[7 * 33]);
        *(u32x4*)(WT + (size_t)(ndst0 + n) * ldt + k0 + 8 * c) = o; }
    LDS_WAIT();
}

template <bool DO_LN, bool DO_GATES>
__device__ __forceinline__ void row_pass(const float* src, float* dstf, bf16_t* dstb, const float* g, const float* bt, const float* Wg, float* G, int gw, int ngw, int lane) {
    for (int m = gw; m < M; m += ngw) {
        const f32x4* xr = (const f32x4*)(src + (size_t)m * DM) + lane;
        f32x4 v[4];
#pragma unroll
        for (int j = 0; j < 4; ++j) v[j] = xr[64 * j];
        if (DO_LN) {
            float s = 0.f;
#pragma unroll
            for (int j = 0; j < 4; ++j) s += (v[j].x + v[j].y) + (v[j].z + v[j].w);
            const float mean = wave_sum(s) * (1.f / DM); float s2 = 0.f;
#pragma unroll
            for (int j = 0; j < 4; ++j) { v[j] = v[j] - mean; s2 += (v[j].x * v[j].x + v[j].y * v[j].y) + (v[j].z * v[j].z + v[j].w * v[j].w); }
            const float rstd = 1.f / sqrtf(wave_sum(s2) * (1.f / DM) + LN_EPS);
            f32x4* of = (f32x4*)(dstf + (size_t)m * DM) + lane;
#pragma unroll
            for (int j = 0; j < 4; ++j) { const f32x4 gg = ((const f32x4*)g)[lane + 64 * j], bb = ((const f32x4*)bt)[lane + 64 * j]; v[j] = v[j] * rstd * gg + bb; of[64 * j] = v[j]; }
        }
        u32x2* ob = (u32x2*)(dstb + (size_t)m * DM) + lane;
#pragma unroll
        for (int j = 0; j < 4; ++j) { u32x2 w; w.x = pk_bf16(v[j].x, v[j].y); w.y = pk_bf16(v[j].z, v[j].w); ob[64 * j] = w; }
        if (DO_GATES) {
            float keep = 0.f;
#pragma unroll
            for (int jg = 0; jg < 8; ++jg) { float s = 0.f;
#pragma unroll
                for (int j = 0; j < 4; ++j) { const f32x4 w = ((const f32x4*)(Wg + jg * DM))[lane + 64 * j]; s += (v[j].x * w.x + v[j].y * w.y) + (v[j].z * w.z + v[j].w * w.w); }
                s = wave_sum(s); if (lane == jg) keep = s; }
            if (lane < 8) G[(size_t)m * 8 + lane] = keep;
        }
    }
}

constexpr int AT_KB = 64 * 272, AT_VB = 64 * 256, AT_V0 = 2 * AT_KB;
__device__ __forceinline__ void attn_unit(LAS unsigned char* lds, const bf16_t* U, bf16_t* CAT, int b, int h, int qb, float lam, float out_scale, const float* gnorm, int tid) {
    asm volatile("" : "+v"(tid));
    const int lane = tid & 63, wid = __builtin_amdgcn_readfirstlane(tid >> 6), r32 = lane & 31, hi = lane >> 5;
    const int mp = wid >> 2, wq = wid & 3;
    const size_t rowbase = (size_t)b * SEQ;
    const int q0 = qb * 128 + wq * 32, qpos = q0 + r32;
    bf16x8 qf[4];
    { const bf16_t* qptr = U + (rowbase + qpos) * NU + UC_DQ + h * 128 + mp * 64 + hi * 8;
#pragma unroll
      for (int d0 = 0; d0 < 4; ++d0) qf[d0] = *(const bf16x8*)(qptr + 16 * d0); }
    const int nt = 2 * qb + 2;
    const bf16_t* kg = U + rowbase * NU + UC_DK + h * 128;
    const bf16_t* vg = U + rowbase * NU + UC_DV + h * 128;
    u32x4 kr[2], vr[2];
#define A_GLOADK(t) do { _Pragma("unroll") for (int i_ = 0; i_ < 2; ++i_) { const int c_ = tid + 512 * i_, row_ = c_ >> 4, ch_ = c_ & 15; kr[i_] = *(const u32x4*)(kg + (size_t)(64 * (t) + row_) * NU + ch_ * 8); } } while (0)
#define A_GLOADV(t) do { _Pragma("unroll") for (int i_ = 0; i_ < 2; ++i_) { const int c_ = tid + 512 * i_, row_ = c_ >> 4, ch_ = c_ & 15; vr[i_] = *(const u32x4*)(vg + (size_t)(64 * (t) + row_) * NU + ch_ * 8); } } while (0)
#define A_STOREK(bs) do { _Pragma("unroll") for (int i_ = 0; i_ < 2; ++i_) { const int c_ = tid + 512 * i_, row_ = c_ >> 4, ch_ = c_ & 15; *(LAS u32x4*)(lds + (bs) * AT_KB + row_ * 272 + ch_ * 16) = kr[i_]; } } while (0)
#define A_STOREV(bs) do { _Pragma("unroll") for (int i_ = 0; i_ < 2; ++i_) { const int c_ = tid + 512 * i_, row_ = c_ >> 4, ch_ = c_ & 15; \
        *(LAS u32x4*)(lds + AT_V0 + (bs) * AT_VB + ((row_ >> 3) * 4 + (ch_ >> 2)) * 512 + (row_ & 7) * 64 + (ch_ & 3) * 16) = vr[i_]; } } while (0)
#define A_QK(S0, S1, bs) do { const LAS unsigned char* Kb_ = lds + (bs) * AT_KB + r32 * 272 + (mp * 64 + 8 * hi) * 2; \
        _Pragma("unroll") for (int r_ = 0; r_ < 16; ++r_) { S0[r_] = 0.f; S1[r_] = 0.f; } \
        _Pragma("unroll") for (int d0 = 0; d0 < 4; ++d0) { const bf16x8 k0f = *(const LAS bf16x8*)(Kb_ + d0 * 32); const bf16x8 k1f = *(const LAS bf16x8*)(Kb_ + 32 * 272 + d0 * 32); \
            S0 = mfma32(k0f, qf[d0], S0); S1 = mfma32(k1f, qf[d0], S1); } } while (0)
    f32x16 o[4];
#pragma unroll
    for (int k = 0; k < 4; ++k)
#pragma unroll
        for (int r = 0; r < 16; ++r) o[k][r] = 0.f;
    float m_run = -INFINITY, l_run = 0.f;
    const float C = 0.125f * 1.4426950408889634f;
    const int vboff = (4 * hi + ((lane & 15) >> 2)) * 64 + ((lane >> 4) & 1) * 32 + (lane & 3) * 8;
    A_GLOADK(0); A_GLOADV(0); A_STOREK(0); A_STOREV(0); A_GLOADK(1); A_STOREK(1); __syncthreads();
    f32x16 sc0, sc1, sn0, sn1;
    A_QK(sc0, sc1, 0);
    for (int t = 0; t < nt; ++t) {
        if (t + 2 < nt) A_GLOADK(t + 2);
        if (t + 1 < nt) A_GLOADV(t + 1);
        const bool act_next = (t + 1 < nt) && (64 * (t + 1) <= q0 + 31);
        if (act_next) A_QK(sn0, sn1, (t + 1) & 1);
        if (64 * t <= q0 + 31) {
            if (64 * t + 63 > q0) {
#pragma unroll
                for (int r = 0; r < 16; ++r) { const int key = 64 * t + crow(r, hi); if (key > qpos) sc0[r] = -INFINITY; if (key + 32 > qpos) sc1[r] = -INFINITY; }
            }
            float mxa = __builtin_fmaxf(__builtin_fmaxf(sc0[0], sc0[1]), sc1[0]), mxb = __builtin_fmaxf(__builtin_fmaxf(sc0[2], sc0[3]), sc1[1]);
            mxa = __builtin_fmaxf(__builtin_fmaxf(mxa, sc1[2]), sc1[3]);
#pragma unroll
            for (int r = 4; r < 16; r += 4) { mxa = __builtin_fmaxf(__builtin_fmaxf(mxa, sc0[r]), sc0[r + 1]); mxb = __builtin_fmaxf(__builtin_fmaxf(mxb, sc0[r + 2]), sc0[r + 3]);
                mxa = __builtin_fmaxf(__builtin_fmaxf(mxa, sc1[r]), sc1[r + 1]); mxb = __builtin_fmaxf(__builtin_fmaxf(mxb, sc1[r + 2]), sc1[r + 3]); }
            float mx = __builtin_fmaxf(mxa, mxb) * C;
            mx = __builtin_fmaxf(mx, __shfl_xor(mx, 32));
            if (__any(mx > m_run + 8.f)) {
                const float mn = __builtin_fmaxf(m_run, mx); const float f = __builtin_amdgcn_exp2f(m_run - mn); m_run = mn; l_run *= f;
#pragma unroll
                for (int k = 0; k < 4; ++k)
#pragma unroll
                    for (int r = 0; r < 16; ++r) o[k][r] *= f;
            }
            const float nm = -m_run;
            float ls0 = 0.f, ls1 = 0.f;
#pragma unroll
            for (int r = 0; r < 16; ++r) { sc0[r] = __builtin_amdgcn_exp2f(__builtin_fmaf(sc0[r], C, nm)); sc1[r] = __builtin_amdgcn_exp2f(__builtin_fmaf(sc1[r], C, nm)); ls0 += sc0[r]; ls1 += sc1[r]; }
            l_run += ls0 + ls1;
            bf16x8 pf[4];
            { u32x4 w;
              w.x = pk_bf16(sc0[0], sc0[1]); w.y = pk_bf16(sc0[2], sc0[3]); w.z = pk_bf16(sc0[4], sc0[5]); w.w = pk_bf16(sc0[6], sc0[7]); pf[0] = __builtin_bit_cast(bf16x8, w);
              w.x = pk_bf16(sc0[8], sc0[9]); w.y = pk_bf16(sc0[10], sc0[11]); w.z = pk_bf16(sc0[12], sc0[13]); w.w = pk_bf16(sc0[14], sc0[15]); pf[1] = __builtin_bit_cast(bf16x8, w);
              w.x = pk_bf16(sc1[0], sc1[1]); w.y = pk_bf16(sc1[2], sc1[3]); w.z = pk_bf16(sc1[4], sc1[5]); w.w = pk_bf16(sc1[6], sc1[7]); pf[2] = __builtin_bit_cast(bf16x8, w);
              w.x = pk_bf16(sc1[8], sc1[9]); w.y = pk_bf16(sc1[10], sc1[11]); w.z = pk_bf16(sc1[12], sc1[13]); w.w = pk_bf16(sc1[14], sc1[15]); pf[3] = __builtin_bit_cast(bf16x8, w); }
            const LAS unsigned char* vb = lds + AT_V0 + (t & 1) * AT_VB + vboff;
#pragma unroll
            for (int ks = 0; ks < 4; ++ks)
#pragma unroll
                for (int blk = 0; blk < 4; ++blk) {
                    const s16x4 lo = __builtin_bit_cast(s16x4, __builtin_amdgcn_ds_read_tr16_b64_v4i16((LAS s16x4*)(vb + ks * 4096 + blk * 512)));
                    const s16x4 hh = __builtin_bit_cast(s16x4, __builtin_amdgcn_ds_read_tr16_b64_v4i16((LAS s16x4*)(vb + ks * 4096 + blk * 512 + 2048)));
                    const bf16x8 vf = {lo[0], lo[1], lo[2], lo[3], hh[0], hh[1], hh[2], hh[3]};
                    o[blk] = mfma32(vf, pf[ks], o[blk]);
                }
        }
        if (act_next) { sc0 = sn0; sc1 = sn1; }
        if (t + 2 < nt) A_STOREK(t & 1);
        if (t + 1 < nt) A_STOREV((t + 1) & 1);
        __syncthreads();
    }
#undef A_GLOADK
#undef A_GLOADV
#undef A_STOREK
#undef A_STOREV
#undef A_QK
    l_run += __shfl_xor(l_run, 32);
    const float inv = 1.f / l_run;
    LAS float* X = (LAS float*)lds + wq * 4096 + lane;
    if (mp == 1) {
        const float sc = inv * lam;
#pragma unroll
        for (int k = 0; k < 4; ++k)
#pragma unroll
            for (int r = 0; r < 16; ++r) X[(k * 16 + r) * 64] = o[k][r] * sc;
    }
    __syncthreads();
    if (mp == 0) {
        float ss = 0.f;
#pragma unroll
        for (int k = 0; k < 4; ++k)
#pragma unroll
            for (int r = 0; r < 16; ++r) { const float v = o[k][r] * inv - X[(k * 16 + r) * 64]; o[k][r] = v; ss += v * v; }
        ss += __shfl_xor(ss, 32);
        const float rn = out_scale / sqrtf(ss * (1.f / 128.f) + LN_EPS);
        bf16_t* orow = CAT + (rowbase + qpos) * DM + 512 + h * 128;
#pragma unroll
        for (int k = 0; k < 4; ++k)
#pragma unroll
            for (int r4 = 0; r4 < 4; ++r4) { const int dv = 32 * k + 8 * r4 + 4 * hi; const f32x4 g4 = *(const f32x4*)(gnorm + dv);
                u32x2 w; w.x = pk_bf16(o[k][4 * r4 + 0] * rn * g4.x, o[k][4 * r4 + 1] * rn * g4.y); w.y = pk_bf16(o[k][4 * r4 + 2] * rn * g4.z, o[k][4 * r4 + 3] * rn * g4.w);
                *(u32x2*)(orow + dv) = w; }
    }
    __syncthreads();
}

__device__ __forceinline__ void conv_unit(LAS unsigned char* lds, const bf16_t* U, bf16_t* CAT, int ct, const float* dw_w, const float* dw_b, const float* ln_g, const float* ln_b,
                                          const bf16_t* PwT, const float* pw_b, int tid) {
    asm volatile("" : "+v"(tid));
    const int lane = tid & 63, wid = __builtin_amdgcn_readfirstlane(tid >> 6);
    const int t0 = ct * 64, pos0 = t0 & (SEQ - 1);
    LAS float* Y = (LAS float*)lds;
    for (int id = tid; id < 94 * 32; id += NTHREADS) {
        const int r = id >> 5, c8 = id & 31; const int pos = pos0 - 30 + r;
        f32x4 y0 = {0.f, 0.f, 0.f, 0.f}, y1 = {0.f, 0.f, 0.f, 0.f};
        if (pos >= 0) {
            const bf16_t* up = U + (size_t)(t0 - 30 + r) * NU + 8 * c8;
            const u32x4 a = *(const u32x4*)(up + UC_CA), g = *(const u32x4*)(up + UC_CG);
            y0.x = bf_lo(a.x) * sigmoidf_(bf_lo(g.x)); y0.y = bf_hi(a.x) * sigmoidf_(bf_hi(g.x)); y0.z = bf_lo(a.y) * sigmoidf_(bf_lo(g.y)); y0.w = bf_hi(a.y) * sigmoidf_(bf_hi(g.y));
            y1.x = bf_lo(a.z) * sigmoidf_(bf_lo(g.z)); y1.y = bf_hi(a.z) * sigmoidf_(bf_hi(g.z)); y1.z = bf_lo(a.w) * sigmoidf_(bf_lo(g.w)); y1.w = bf_hi(a.w) * sigmoidf_(bf_hi(g.w));
        }
        *(LAS f32x4*)(Y + r * 256 + 8 * c8) = y0; *(LAS f32x4*)(Y + r * 256 + 8 * c8 + 4) = y1;
    }
    __syncthreads();
    f32x4 acc[8];
    { const f32x4 bias = *(const f32x4*)(dw_b + 4 * lane);
#pragma unroll
      for (int j = 0; j < 8; ++j) acc[j] = bias; }
#pragma unroll 1
    for (int tp = 0; tp < 31; ++tp) {
        const f32x4 w = *(const f32x4*)(dw_w + tp * 256 + 4 * lane);
        const LAS f32x4* yp = (const LAS f32x4*)(Y + (8 * wid + tp) * 256 + 4 * lane);
#pragma unroll
        for (int j = 0; j < 8; ++j) acc[j] += w * yp[j * 64];
    }
    { const f32x4 gg = *(const f32x4*)(ln_g + 4 * lane), bb = *(const f32x4*)(ln_b + 4 * lane);
#pragma unroll
      for (int j = 0; j < 8; ++j) {
        const float mean = wave_sum((acc[j].x + acc[j].y) + (acc[j].z + acc[j].w)) * (1.f / 256.f);
        f32x4 d = acc[j] - mean;
        const float var = wave_sum((d.x * d.x + d.y * d.y) + (d.z * d.z + d.w * d.w)) * (1.f / 256.f);
        const float rstd = 1.f / sqrtf(var + LN_EPS);
        d = d * rstd * gg + bb;
        d.x = d.x * sigmoidf_(d.x); d.y = d.y * sigmoidf_(d.y); d.z = d.z * sigmoidf_(d.z); d.w = d.w * sigmoidf_(d.w);
        acc[j] = d; } }
    __syncthreads();
    LAS unsigned char* At = lds;
#pragma unroll
    for (int j = 0; j < 8; ++j) { u32x2 w; w.x = pk_bf16(acc[j].x, acc[j].y); w.y = pk_bf16(acc[j].z, acc[j].w); *(LAS u32x2*)(At + (8 * wid + j) * 528 + lane * 8) = w; }
    __syncthreads();
    const int fr = lane & 15, fq = lane >> 4;
    f32x4 c[4][2];
#pragma unroll
    for (int mb = 0; mb < 4; ++mb)
#pragma unroll
        for (int nb = 0; nb < 2; ++nb) c[mb][nb] = (f32x4){0.f, 0.f, 0.f, 0.f};
#pragma unroll
    for (int ks = 0; ks < 8; ++ks) {
        bf16x8 bf[2], af[4];
#pragma unroll
        for (int nb = 0; nb < 2; ++nb) bf[nb] = *(const bf16x8*)(PwT + (size_t)(32 * wid + 16 * nb + fr) * 256 + 32 * ks + 8 * fq);
#pragma unroll
        for (int mb = 0; mb < 4; ++mb) af[mb] = *(const LAS bf16x8*)(At + (16 * mb + fr) * 528 + (32 * ks + 8 * fq) * 2);
#pragma unroll
        for (int mb = 0; mb < 4; ++mb)
#pragma unroll
            for (int nb = 0; nb < 2; ++nb) c[mb][nb] = mfma16(bf[nb], af[mb], c[mb][nb]);
    }
#pragma unroll
    for (int nb = 0; nb < 2; ++nb) { const int col = 32 * wid + 16 * nb + 4 * fq; const f32x4 bb = *(const f32x4*)(pw_b + col);
#pragma unroll
        for (int mb = 0; mb < 4; ++mb) { const f32x4 v = c[mb][nb] + bb; u32x2 w; w.x = pk_bf16(v.x, v.y); w.y = pk_bf16(v.z, v.w);
            *(u32x2*)(CAT + (size_t)(t0 + 16 * mb + fr) * DM + col) = w; } }
    __syncthreads();
}

#define ML_LAUNDER() int tid = tid_in; asm volatile("" : "+v"(tid)); const int lane = tid & 63, fr = lane & 15, fq = lane >> 4; (void)lane; (void)fr; (void)fq
__device__ __forceinline__ unsigned ld_agent(const unsigned* p) { return __hip_atomic_load(p, __ATOMIC_RELAXED, __HIP_MEMORY_SCOPE_AGENT); }
#define ML_SCAN_CORE() \
    const float lf0 = sLF[2 * lane], lf1 = sLF[2 * lane + 1], li0 = sLI[2 * lane], li1 = sLI[2 * lane + 1]; \
    const float c1 = lf0 + lf1; float tot = c1; \
    _Pragma("unroll") for (int o = 1; o < 64; o <<= 1) { const float t_ = __shfl_up(tot, o); if (lane >= o) tot += t_; } \
    const float excl = tot - c1; const float b0 = excl + lf0, b1 = excl + c1; \
    const float g = __shfl(tot, 63); \
    const float ct0 = li0 - b0, ct1 = li1 - b1; \
    const float pm1 = fmaxf(ct0, ct1); float sm = pm1; \
    _Pragma("unroll") for (int o = 1; o < 64; o <<= 1) { const float t_ = __shfl_up(sm, o); if (lane >= o) sm = fmaxf(sm, t_); } \
    float ex = __shfl_up(sm, 1); if (lane == 0) ex = -INFINITY; \
    const float pmax0 = fmaxf(ex, ct0), pmax1 = fmaxf(ex, pm1); \
    const float pall = __shfl(sm, 63); (void)pmax0; (void)pmax1; (void)b0; (void)b1

constexpr int S1_RAW = 0, S1_VT = 18944, S1_KPT = 40704, S1_SM = 58112;
__device__ __forceinline__ void ml_stage1(LAS unsigned char* lds, const bf16_t* U, const float* G, float* CL, float* MS, unsigned* cnt1, int bh, int ch, const float* b_ig, const float* b_fg,
                                          const float* cw, const float* cb, int tid_in) {
    const int wid = __builtin_amdgcn_readfirstlane(tid_in >> 6);
    const int b = bh >> 2, h = bh & 3, item = bh * 64 + ch;
    LAS float* SM = (LAS float*)(lds + S1_SM);
    LAS float* sLI = SM, *sLF = SM + 128, *sKS = SM + 256;
    const size_t rowbase = (size_t)b * SEQ, row0 = rowbase + (size_t)ch * 128;
    {   ML_LAUNDER();
        for (int i = tid; i < 16 * 136 / 2; i += NTHREADS) ((LAS unsigned*)(lds + S1_VT + 64 * 272))[i] = (i < 68) ? 0x3f803f80u : 0u;
        if (tid < 128) {
            const float gi = G[(row0 + tid) * 8 + h] + b_ig[h], gf = G[(row0 + tid) * 8 + 4 + h] + b_fg[h];
            sLI[tid] = gi; sLF[tid] = fminf(gf, 0.f) - log1pf(__expf(-fabsf(gf)));
        }
#pragma unroll
        for (int i = 0; i < 3; ++i) {
            const int id = tid + 512 * i;
            if (id < 131 * 8) {
                const int r = id >> 3, c = id & 7; const int pos = ch * 128 - 3 + r;
                u32x4 x = {0u, 0u, 0u, 0u};
                if (pos >= 0) x = *(const u32x4*)(U + (rowbase + pos) * NU + UC_MQK + 256 + 64 * h + 8 * c);
                *(LAS u32x4*)(lds + S1_RAW + r * 144 + c * 16) = x;
            }
        }
#pragma unroll
        for (int i = 0; i < 2; ++i) {
            const int id = tid + 512 * i, s = id & 127, vg8 = id >> 7;
            const u32x4 x = *(const u32x4*)(U + (row0 + s) * NU + UC_MV + 64 * h + 8 * vg8);
            LAS bf16_t* vt = (LAS bf16_t*)(lds + S1_VT) + (8 * vg8) * 136 + s;
            vt[0 * 136] = (bf16_t)(x.x & 0xffffu); vt[1 * 136] = (bf16_t)(x.x >> 16); vt[2 * 136] = (bf16_t)(x.y & 0xffffu); vt[3 * 136] = (bf16_t)(x.y >> 16);
            vt[4 * 136] = (bf16_t)(x.z & 0xffffu); vt[5 * 136] = (bf16_t)(x.z >> 16); vt[6 * 136] = (bf16_t)(x.w & 0xffffu); vt[7 * 136] = (bf16_t)(x.w >> 16);
        }
    }
    __syncthreads();
    if (wid == 0) {
        ML_LAUNDER();
        ML_SCAN_CORE();
        const float m_loc = g + pall;
        sKS[2 * lane] = __expf(g + ct0 - m_loc); sKS[2 * lane + 1] = __expf(g + ct1 - m_loc);
        if (lane == 0) { MS[item] = g; MS[1024 + item] = m_loc; }
    }
    __syncthreads();
    {   ML_LAUNDER();
#pragma unroll
        for (int i = 0; i < 2; ++i) {
            const int id = tid + 512 * i, s = id & 127, c = id >> 7;
            const int c0 = 256 + 64 * h + 8 * c;
            float y[8];
            { const f32x4 b0 = *(const f32x4*)(cb + c0), b1 = *(const f32x4*)(cb + c0 + 4); y[0] = b0.x; y[1] = b0.y; y[2] = b0.z; y[3] = b0.w; y[4] = b1.x; y[5] = b1.y; y[6] = b1.z; y[7] = b1.w; }
#pragma unroll
            for (int tp = 0; tp < 4; ++tp) {
                const u32x4 x = *(const LAS u32x4*)(lds + S1_RAW + (s + tp) * 144 + c * 16);
                const f32x4 w0 = *(const f32x4*)(cw + tp * 512 + c0), w1 = *(const f32x4*)(cw + tp * 512 + c0 + 4);
                y[0] += w0.x * bf_lo(x.x); y[1] += w0.y * bf_hi(x.x); y[2] += w0.z * bf_lo(x.y); y[3] += w0.w * bf_hi(x.y);
                y[4] += w1.x * bf_lo(x.z); y[5] += w1.y * bf_hi(x.z); y[6] += w1.z * bf_lo(x.w); y[7] += w1.w * bf_hi(x.w);
            }
            const float sc = 0.125f * sKS[s];
            LAS bf16_t* kp = (LAS bf16_t*)(lds + S1_KPT) + (8 * c) * 136 + s;
#pragma unroll
            for (int e = 0; e < 8; ++e) kp[e * 136] = f2bf(y[e] * sigmoidf_(y[e]) * sc);
        }
    }
    __syncthreads();
    {   ML_LAUNDER();
        float* clp = CL + (size_t)item * 5120;
#pragma unroll
        for (int k = 0; k < 3; ++k) {
            const int bi_ = wid + 8 * k;
            if (bi_ < 20) {
                const int rb = bi_ >> 2, kb = bi_ & 3;
                f32x4 c = {0.f, 0.f, 0.f, 0.f};
#pragma unroll
                for (int ks = 0; ks < 4; ++ks) {
                    const bf16x8 va = *(const LAS bf16x8*)(lds + S1_VT + (16 * rb + fr) * 272 + (32 * ks + 8 * fq) * 2);
                    const bf16x8 kf = *(const LAS bf16x8*)(lds + S1_KPT + (16 * kb + fr) * 272 + (32 * ks + 8 * fq) * 2);
                    c = mfma16(va, kf, c);
                }
                float* p = clp + (16 * rb + 4 * fq) * 64 + 16 * kb + fr;
                p[0] = c[0]; p[64] = c[1]; p[128] = c[2]; p[192] = c[3];
            }
        }
    }
    __builtin_amdgcn_fence(__ATOMIC_RELEASE, "agent");
    __syncthreads();
    if (tid_in == 0) __hip_atomic_fetch_add(cnt1, 1u, __ATOMIC_RELAXED, __HIP_MEMORY_SCOPE_AGENT);
}

__device__ __forceinline__ void ml_scan(const float* CL, bf16_t* CP, float* MS, const unsigned* cnt1, unsigned* flag2, int bh, int tid) {
    if (tid == 0) { while (ld_agent(cnt1) < 64u) __builtin_amdgcn_s_sleep(4); }
    __syncthreads();
    __builtin_amdgcn_fence(__ATOMIC_ACQUIRE, "agent");
    float c[9], nx[9];
#pragma unroll
    for (int i = 0; i < 9; ++i) c[i] = 0.f;
    float m = 0.f;
    const float* cl = CL + (size_t)(bh * 64) * 5120;
#pragma unroll
    for (int i = 0; i < 9; ++i) { const int idx = tid + 512 * i; nx[i] = (idx < 4160) ? cl[idx] : 0.f; }
    for (int ch = 0; ch < 64; ++ch) {
        const int item = bh * 64 + ch;
        const float g = MS[item], ml = MS[1024 + item];
        if (tid == 0) MS[2048 + item] = m;
        bf16_t* cp = CP + (size_t)item * 5120;
        float cur[9];
#pragma unroll
        for (int i = 0; i < 9; ++i) { const int idx = tid + 512 * i; if (idx < 4160) cp[idx] = f2bf(c[i]); cur[i] = nx[i]; }
        if (ch + 1 < 64) {
#pragma unroll
            for (int i = 0; i < 9; ++i) { const int idx = tid + 512 * i; nx[i] = (idx < 4160) ? cl[(size_t)(ch + 1) * 5120 + idx] : 0.f; }
        }
        const float m_new = fmaxf(g + m, ml), a = __expf(g + m - m_new), e = __expf(ml - m_new);
#pragma unroll
        for (int i = 0; i < 9; ++i) c[i] = a * c[i] + e * cur[i];
        m = m_new;
    }
    __builtin_amdgcn_fence(__ATOMIC_RELEASE, "agent");
    __syncthreads();
    if (tid == 0) __hip_atomic_store(flag2, 1u, __ATOMIC_RELAXED, __HIP_MEMORY_SCOPE_AGENT);
}

constexpr int S3_Q = 0, S3_K = 18432, S3_VT = 36864, S3_P = 58624, S3_CB = 94528, S3_SM = 106048;
__device__ __forceinline__ void ml_stage3(LAS unsigned char* lds, const bf16_t* U, const float* G, const bf16_t* CP, const float* MS, const unsigned* flag2, bf16_t* CAT, int bh, int ch,
                                          const float* b_ig, const float* b_fg, const float* cw, const float* cb, const float* ng, int tid_in) {
    const int wid = __builtin_amdgcn_readfirstlane(tid_in >> 6);
    const int b = bh >> 2, h = bh & 3, item = bh * 64 + ch;
    LAS float* SM = (LAS float*)(lds + S3_SM);
    LAS float* sLI = SM, *sLF = SM + 128, *sROW = SM + 256, *sCOL = SM + 384, *sAI = SM + 512, *sEN = SM + 640, *sRS = SM + 768;
    const size_t rowbase = (size_t)b * SEQ, row0 = rowbase + (size_t)ch * 128;
    if (tid_in == 0) { while (ld_agent(flag2) == 0u) __builtin_amdgcn_s_sleep(4); }
    __syncthreads();
    __builtin_amdgcn_fence(__ATOMIC_ACQUIRE, "agent");
    const float m_prev = MS[2048 + item];
    {   ML_LAUNDER();
        if (tid < 128) {
            const float gi = G[(row0 + tid) * 8 + h] + b_ig[h], gf = G[(row0 + tid) * 8 + 4 + h] + b_fg[h];
            sLI[tid] = gi; sLF[tid] = fminf(gf, 0.f) - log1pf(__expf(-fabsf(gf)));
        }
#pragma unroll
        for (int i = 0; i < 5; ++i) {
            const int id = tid + 512 * i;
            if (id < 131 * 16) {
                const int r = id >> 4, c = id & 15; const int pos = ch * 128 - 3 + r;
                u32x4 x = {0u, 0u, 0u, 0u};
                if (pos >= 0) x = *(const u32x4*)(U + (rowbase + pos) * NU + UC_MQK + ((c < 8) ? (64 * h + 8 * c) : (256 + 64 * h + 8 * (c - 8))));
                *(LAS u32x4*)(lds + S3_P + r * 272 + c * 16) = x;
            }
        }
#pragma unroll
        for (int i = 0; i < 2; ++i) {
            const int id = tid + 512 * i, s = id & 127, vg8 = id >> 7;
            const u32x4 x = *(const u32x4*)(U + (row0 + s) * NU + UC_MV + 64 * h + 8 * vg8);
            LAS bf16_t* vt = (LAS bf16_t*)(lds + S3_VT) + (8 * vg8) * 136 + s;
            vt[0 * 136] = (bf16_t)(x.x & 0xffffu); vt[1 * 136] = (bf16_t)(x.x >> 16); vt[2 * 136] = (bf16_t)(x.y & 0xffffu); vt[3 * 136] = (bf16_t)(x.y >> 16);
            vt[4 * 136] = (bf16_t)(x.z & 0xffffu); vt[5 * 136] = (bf16_t)(x.z >> 16); vt[6 * 136] = (bf16_t)(x.w & 0xffffu); vt[7 * 136] = (bf16_t)(x.w >> 16);
        }
#pragma unroll
        for (int i = 0; i < 2; ++i) {
            const int id = tid + 512 * i;
            if (id < 80 * 9) {
                const int r = id / 9, c = id - 9 * r;
                u32x4 x = {0u, 0u, 0u, 0u};
                if (r < 65 && c < 8) x = *(const u32x4*)(CP + (size_t)item * 5120 + r * 64 + 8 * c);
                *(LAS u32x4*)(lds + S3_CB + r * 144 + c * 16) = x;
            }
        }
    }
    __syncthreads();
    if (wid == 0) {
        ML_LAUNDER();
        ML_SCAN_CORE();
        (void)g; (void)pall;
        const float M0 = fmaxf(m_prev, pmax0), M1 = fmaxf(m_prev, pmax1);
        sROW[2 * lane] = -M0; sROW[2 * lane + 1] = -M1;
        sCOL[2 * lane] = ct0; sCOL[2 * lane + 1] = ct1;
        sAI[2 * lane] = __expf(m_prev - M0); sAI[2 * lane + 1] = __expf(m_prev - M1);
        sEN[2 * lane] = __expf(-(b0 + M0)); sEN[2 * lane + 1] = __expf(-(b1 + M1));
    }
    {   ML_LAUNDER();
#pragma unroll
        for (int i = 0; i < 4; ++i) {
            const int id = tid + 512 * i, j = id >> 4, c = id & 15;
            const int c0 = (c < 8) ? (64 * h + 8 * c) : (256 + 64 * h + 8 * (c - 8));
            float y[8];
            { const f32x4 b0 = *(const f32x4*)(cb + c0), b1 = *(const f32x4*)(cb + c0 + 4); y[0] = b0.x; y[1] = b0.y; y[2] = b0.z; y[3] = b0.w; y[4] = b1.x; y[5] = b1.y; y[6] = b1.z; y[7] = b1.w; }
#pragma unroll
            for (int tp = 0; tp < 4; ++tp) {
                const u32x4 x = *(const LAS u32x4*)(lds + S3_P + (j + tp) * 272 + c * 16);
                const f32x4 w0 = *(const f32x4*)(cw + tp * 512 + c0), w1 = *(const f32x4*)(cw + tp * 512 + c0 + 4);
                y[0] += w0.x * bf_lo(x.x); y[1] += w0.y * bf_hi(x.x); y[2] += w0.z * bf_lo(x.y); y[3] += w0.w * bf_hi(x.y);
                y[4] += w1.x * bf_lo(x.z); y[5] += w1.y * bf_hi(x.z); y[6] += w1.z * bf_lo(x.w); y[7] += w1.w * bf_hi(x.w);
            }
            const float sc = (c < 8) ? 1.f : 0.125f;
#pragma unroll
            for (int e = 0; e < 8; ++e) y[e] = y[e] * sigmoidf_(y[e]) * sc;
            u32x4 w; w.x = pk_bf16(y[0], y[1]); w.y = pk_bf16(y[2], y[3]); w.z = pk_bf16(y[4], y[5]); w.w = pk_bf16(y[6], y[7]);
            *(LAS u32x4*)(lds + ((c < 8) ? S3_Q : S3_K) + j * 144 + (c & 7) * 16) = w;
        }
    }
    __syncthreads();
    {   ML_LAUNDER();
        const int j = 16 * wid + fr;
        bf16x8 qfr[2];
#pragma unroll
        for (int ks = 0; ks < 2; ++ks) qfr[ks] = *(const LAS bf16x8*)(lds + S3_Q + j * 144 + (32 * ks + 8 * fq) * 2);
        const float rowt = sROW[j]; float rs = 0.f;
#pragma unroll
        for (int sb = 0; sb < 8; ++sb) {
            f32x4 sacc = {0.f, 0.f, 0.f, 0.f};
#pragma unroll
            for (int ks = 0; ks < 2; ++ks) { const bf16x8 kf = *(const LAS bf16x8*)(lds + S3_K + (16 * sb + fr) * 144 + (32 * ks + 8 * fq) * 2); sacc = mfma16(kf, qfr[ks], sacc); }
            const int s0 = 16 * sb + 4 * fq; float p[4];
#pragma unroll
            for (int e = 0; e < 4; ++e) { const int s = s0 + e; const float v = sacc[e] * __expf(rowt + sCOL[s]); p[e] = (s <= j) ? v : 0.f; rs += p[e]; }
            u32x2 w; w.x = pk_bf16(p[0], p[1]); w.y = pk_bf16(p[2], p[3]);
            *(LAS u32x2*)(lds + S3_P + j * 272 + s0 * 2) = w;
        }
        rs += __shfl_xor(rs, 16); rs += __shfl_xor(rs, 32);
        if (fq == 0) sRS[j] = rs;
    }
    LDS_WAIT();
    {   ML_LAUNDER();
        f32x4 acc[5];
#pragma unroll
        for (int vb = 0; vb < 5; ++vb) acc[vb] = (f32x4){0.f, 0.f, 0.f, 0.f};
#pragma unroll
        for (int ks = 0; ks < 2; ++ks) {
            const bf16x8 qa = *(const LAS bf16x8*)(lds + S3_Q + (16 * wid + fr) * 144 + (32 * ks + 8 * fq) * 2);
#pragma unroll
            for (int vb = 0; vb < 5; ++vb) { const bf16x8 cf = *(const LAS bf16x8*)(lds + S3_CB + (16 * vb + fr) * 144 + (32 * ks + 8 * fq) * 2); acc[vb] = mfma16(qa, cf, acc[vb]); }
        }
        const int jb = 16 * wid + 4 * fq;
        float ai[4], den[4];
#pragma unroll
        for (int e = 0; e < 4; ++e) ai[e] = sAI[jb + e];
#pragma unroll
        for (int vb = 0; vb < 5; ++vb)
#pragma unroll
            for (int e = 0; e < 4; ++e) acc[vb][e] *= ai[e];
#pragma unroll
        for (int e = 0; e < 4; ++e) { const float nq = __shfl(acc[4][e], lane & 48); den[e] = nq + sRS[jb + e]; den[e] = fmaxf(fabsf(den[e]), sEN[jb + e]); }
#pragma unroll
        for (int ks = 0; ks < 4; ++ks) {
            const bf16x8 pa = *(const LAS bf16x8*)(lds + S3_P + (16 * wid + fr) * 272 + (32 * ks + 8 * fq) * 2);
#pragma unroll
            for (int vb = 0; vb < 4; ++vb) { const bf16x8 vf = *(const LAS bf16x8*)(lds + S3_VT + (16 * vb + fr) * 272 + (32 * ks + 8 * fq) * 2); acc[vb] = mfma16(pa, vf, acc[vb]); }
        }
#pragma unroll
        for (int e = 0; e < 4; ++e) {
            const size_t row = row0 + jb + e;
            float hv[4]; float s = 0.f;
#pragma unroll
            for (int vb = 0; vb < 4; ++vb) { const float og = sigmoidf_(bf2f(U[row * NU + UC_MO + 64 * h + 16 * vb + fr])); hv[vb] = acc[vb][e] / den[e] * og; s += hv[vb]; }
            s += __shfl_xor(s, 1); s += __shfl_xor(s, 2); s += __shfl_xor(s, 4); s += __shfl_xor(s, 8);
            const float mean = s * (1.f / 64.f); float q = 0.f;
#pragma unroll
            for (int vb = 0; vb < 4; ++vb) { hv[vb] -= mean; q += hv[vb] * hv[vb]; }
            q += __shfl_xor(q, 1); q += __shfl_xor(q, 2); q += __shfl_xor(q, 4); q += __shfl_xor(q, 8);
            const float rstd = 1.f / sqrtf(q * (1.f / 64.f) + LN_EPS);
#pragma unroll
            for (int vb = 0; vb < 4; ++vb) CAT[row * DM + 256 + 64 * h + 16 * vb + fr] = f2bf(hv[vb] * rstd * ng[64 * h + 16 * vb + fr]);
        }
    }
    __syncthreads();
}

template <int l> __device__ __forceinline__ void run_layer(const Args& args, LAS unsigned char* lds, const XcdBarrier& xbar) {
    const int G = gridDim.x, bx = blockIdx.x;
#define PHASE_IDS() int tid = threadIdx.x; asm volatile("" : "+v"(tid)); const int lane = tid & 63, wid = __builtin_amdgcn_readfirstlane(tid >> 6); const int gw = bx * NWAVES + wid, ngw = G * NWAVES; (void)lane; (void)gw; (void)ngw
    unsigned char* ws = args.ws;
    unsigned* ctl = (unsigned*)(ws + WS_CTL);
    bf16_t* WinT = (bf16_t*)(ws + WS_WIN); bf16_t* WoT = (bf16_t*)(ws + WS_WOUT); bf16_t* WupT = (bf16_t*)(ws + WS_WUP); bf16_t* WdT = (bf16_t*)(ws + WS_WDN);
    bf16_t* PwT = (bf16_t*)(ws + WS_PW); float* Wg = (float*)(ws + WS_WG); float* Gt = (float*)(ws + WS_G);
    bf16_t* XB = (bf16_t*)(ws + WS_XB); bf16_t* CAT = (bf16_t*)(ws + WS_CAT); bf16_t* Ub = (bf16_t*)(ws + WS_U); bf16_t* HID = (bf16_t*)(ws + WS_U);
    float* out = args.out;
    const float* x_in = args.in[0];
        {
            pg8::Gemm g{XB, WinT + (size_t)l * NU * DM, M, NU, DM}; pg8::StaticOrder S; S.init(M, NU, G, bx);
            pg8::EpiBf16<0> E{Ub, NU};
            pg8::gemm_phase<pg8::EpiBf16<0>, pg8::StaticOrder, true, true>(lds, g, S, E);
        }
        xcd_barrier(xbar);
        {
            PHASE_IDS();
            const float lam = ((const float*)ctl)[128 + l];
            const float linit = 0.8f - 0.6f * expf(-0.3f * (float)l);
            LAS int* sitem = (LAS int*)(lds + 140 * 1024);
            constexpr int N_S1 = 1024, N_SC = 16, N_AT = 1024, N_S3 = 1024, N_CV = 512;
            constexpr int E_S1 = N_S1, E_SC = E_S1 + N_SC, E_AT = E_SC + N_AT, E_S3 = E_AT + N_S3, E_CV = E_S3 + N_CV;
            float* CLb = (float*)(ws + WS_CL); bf16_t* CPb = (bf16_t*)(ws + WS_CP); float* MSb = (float*)(ws + WS_MS);
            unsigned* cnt1 = ctl + 1024 + l * 1024; unsigned* flag2 = ctl + 4096 + l * 1024;
#define FETCH_ITEM() do { if (tid == 0) sitem[0] = (int)atomicAdd(ctl + 64 * l, 1u); __syncthreads(); item = sitem[0]; __syncthreads(); } while (0)
            int item; FETCH_ITEM();
            while (item < E_S1) {
                const int bh = item & 15, ch = item >> 4;
                ml_stage1(lds, Ub, Gt, CLb, MSb, cnt1 + 64 * bh, bh, ch, args.in[2] + l * 4, args.in[3] + l * 4, args.in[10] + l * 2048, args.in[11] + l * 512, tid);
                FETCH_ITEM();
            }
            while (item < E_SC) {
                const int bh = item - E_S1;
                ml_scan(CLb, CPb, MSb, cnt1 + 64 * bh, flag2 + 64 * bh, bh, tid);
                FETCH_ITEM();
            }
            while (item < E_AT) {
                const int idx = item - E_SC; const int qb = 63 - (idx >> 4), bh = idx & 15;
                attn_unit(lds, Ub, CAT, bh >> 2, bh & 3, qb, lam, 1.f - linit, args.in[17] + l * 128, tid);
                FETCH_ITEM();
            }
            while (item < E_S3) {
                const int idx = item - E_AT; const int bh = idx & 15, ch = idx >> 4;
                ml_stage3(lds, Ub, Gt, CPb, MSb, flag2 + 64 * bh, CAT, bh, ch, args.in[2] + l * 4, args.in[3] + l * 4, args.in[10] + l * 2048, args.in[11] + l * 512, args.in[12] + l * 256, tid);
                FETCH_ITEM();
            }
            while (item < E_CV) {
                conv_unit(lds, Ub, CAT, item - E_S3, args.in[4] + l * 31 * 256, args.in[5] + l * 256, args.in[6] + l * 256, args.in[7] + l * 256, PwT + (size_t)l * 65536, args.in[9] + l * 256, tid);
                FETCH_ITEM();
            }
#undef FETCH_ITEM
        }
        xcd_barrier(xbar);
        {
            pg8::Gemm g{CAT, WoT + (size_t)l * DM * DM, M, DM, DM}; pg8::StaticOrder S; S.init(M, DM, G, bx);
            pg8::EpiRes E{(l == 0) ? x_in : (const float*)out, out, DM, ALPHA};
            pg8::gemm_phase<pg8::EpiRes, pg8::StaticOrder, true, true>(lds, g, S, E);
        }
        xcd_barrier(xbar);
        { PHASE_IDS(); row_pass<true, false>(out, out, XB, args.in[19] + l * DM, args.in[20] + l * DM, nullptr, nullptr, gw, ngw, lane); }
        xcd_barrier(xbar);
        {
            pg8::Gemm g{XB, WupT + (size_t)l * DFF * DM, M, DFF, DM}; pg8::StaticOrder S; S.init(M, DFF, G, bx);
            pg8::EpiBf16<2> E{HID, DFF};
            pg8::gemm_phase<pg8::EpiBf16<2>, pg8::StaticOrder, true, true>(lds, g, S, E);
        }
        xcd_barrier(xbar);
        {
            pg8::Gemm g{HID, WdT + (size_t)l * DM * DFF, M, DM, DFF}; pg8::StaticOrder S; S.init(M, DM, G, bx);
            pg8::EpiRes E{(const float*)out, out, DM, ALPHA};
            pg8::gemm_phase<pg8::EpiRes, pg8::StaticOrder, true, true>(lds, g, S, E);
        }
        xcd_barrier(xbar);
        { PHASE_IDS();
          if (l == 0) row_pass<true, true>(out, out, XB, args.in[23] + l * DM, args.in[24] + l * DM, Wg + 8 * DM, Gt, gw, ngw, lane);
          else row_pass<true, false>(out, out, XB, args.in[23] + l * DM, args.in[24] + l * DM, nullptr, nullptr, gw, ngw, lane); }
        if (l == 0) xcd_barrier(xbar);
}
#undef PHASE_IDS

__global__ void __launch_bounds__(NTHREADS) hymba_fwd(Args args) {
    extern __shared__ __attribute__((aligned(16))) unsigned char lds_raw[];
    LAS unsigned char* lds = (LAS unsigned char*)lds_raw;
    cg::grid_group grid = cg::this_grid();
    volatile LAS unsigned* xst = (volatile LAS unsigned*)(lds + 141 * 1024);
    if (threadIdx.x < 2) xst[threadIdx.x] = 0u;
    __syncthreads();
    const XcdBarrier xbar = xcd_barrier_post((unsigned*)(args.ws + WS_CTL) + 8192, xst);
    const int tid = threadIdx.x, lane = tid & 63, wid = __builtin_amdgcn_readfirstlane(tid >> 6);
    const int G = gridDim.x, bx = blockIdx.x;
    const int gw = bx * NWAVES + wid, ngw = G * NWAVES;
    unsigned char* ws = args.ws;
    unsigned* ctl = (unsigned*)(ws + WS_CTL);
    bf16_t* WinT = (bf16_t*)(ws + WS_WIN); bf16_t* WoT = (bf16_t*)(ws + WS_WOUT); bf16_t* WupT = (bf16_t*)(ws + WS_WUP); bf16_t* WdT = (bf16_t*)(ws + WS_WDN);
    bf16_t* PwT = (bf16_t*)(ws + WS_PW); float* Wg = (float*)(ws + WS_WG); float* Gt = (float*)(ws + WS_G);
    bf16_t* XB = (bf16_t*)(ws + WS_XB); bf16_t* CAT = (bf16_t*)(ws + WS_CAT); bf16_t* Ub = (bf16_t*)(ws + WS_U); bf16_t* HID = (bf16_t*)(ws + WS_U);
    float* out = args.out;
    const float* x_in = args.in[0];

    {
        LAS float* scr = (LAS float*)(lds + wid * 16384);
        constexpr int I_IN = 16 * 96, I_O = 16 * 32, I_UP = 16 * 128, I_DN = 64 * 32, I_PW = 4 * 8, I_L = I_IN + I_O + I_UP + I_DN + I_PW;
        for (int it = gw; it < 2 * I_L; it += ngw) {
            const int l = it / I_L; int r = it % I_L;
            if (r < I_IN) { const int kb = r / 96, nb = r % 96, n0 = 32 * nb; transpose_item(args.in[1] + (size_t)l * DM * NIN, NIN, 64 * kb, n0 + (n0 >= 1536 ? 8 : 0), WinT + (size_t)l * NU * DM, DM, n0, scr, lane); continue; } r -= I_IN;
            if (r < I_O) { const int kb = r / 32, nb = r % 32; transpose_item(args.in[18] + (size_t)l * DM * DM, DM, 64 * kb, 32 * nb, WoT + (size_t)l * DM * DM, DM, 32 * nb, scr, lane); continue; } r -= I_O;
            if (r < I_UP) { const int kb = r / 128, nb = r % 128; transpose_item(args.in[21] + (size_t)l * DM * DFF, DFF, 64 * kb, 32 * nb, WupT + (size_t)l * DFF * DM, DM, 32 * nb, scr, lane); continue; } r -= I_UP;
            if (r < I_DN) { const int kb = r / 32, nb = r % 32; transpose_item(args.in[22] + (size_t)l * DFF * DM, DM, 64 * kb, 32 * nb, WdT + (size_t)l * DM * DFF, DFF, 32 * nb, scr, lane); continue; } r -= I_DN;
            { const int kb = r / 8, nb = r % 8; transpose_item(args.in[8] + (size_t)l * 65536, 256, 64 * kb, 32 * nb, PwT + (size_t)l * 65536, 256, 32 * nb, scr, lane); }
        }
        for (int i = bx * NTHREADS + tid; i < 2 * 8 * DM; i += G * NTHREADS) { const int l = i >> 13, jg = (i >> 10) & 7, k = i & 1023; Wg[i] = args.in[1][(size_t)l * DM * NIN + (size_t)k * NIN + 1536 + jg]; }
        if (bx == 0 && wid == 0) {
#pragma unroll
            for (int l = 0; l < 2; ++l) {
                const float s1 = wave_sum(args.in[13][l * 64 + lane] * args.in[14][l * 64 + lane]);
                const float s2 = wave_sum(args.in[15][l * 64 + lane] * args.in[16][l * 64 + lane]);
                const float linit = 0.8f - 0.6f * expf(-0.3f * (float)l);
                if (lane == 0) ((float*)ctl)[128 + l] = expf(s1) - expf(s2) + linit;
            }
        }
    }
    grid.sync();
    row_pass<false, true>(x_in, nullptr, XB, nullptr, nullptr, Wg, Gt, gw, ngw, lane);
    xcd_barrier(xbar);

    run_layer<0>(args, lds, xbar);
    run_layer<1>(args, lds, xbar);
}

extern "C" void kernel_launch(void* const* d_in, const int* in_sizes, int n_in, void* d_out, int out_size, void* d_ws, size_t ws_size, hipStream_t stream) {
    static int grid = 0;
    if (grid == 0) {
        if (n_in != 25 || out_size != M * DM || ws_size < WS_END) { fprintf(stderr, "kernel_launch: unexpected shapes (n_in %d out %d ws %zu)\n", n_in, out_size, ws_size); grid = -1; return; }
        int dev = 0, cus = 0, per_cu = 0;
        hipGetDevice(&dev); hipDeviceGetAttribute(&cus, hipDeviceAttributeMultiprocessorCount, dev);
        if (hipFuncSetAttribute((const void*)hymba_fwd, hipFuncAttributeMaxDynamicSharedMemorySize, LDS_BYTES) != hipSuccess) { fprintf(stderr, "kernel_launch: hipFuncSetAttribute failed\n"); grid = -1; return; }
        if (hipOccupancyMaxActiveBlocksPerMultiprocessor(&per_cu, (const void*)hymba_fwd, NTHREADS, LDS_BYTES) != hipSuccess || per_cu < 1) { fprintf(stderr, "kernel_launch: occupancy query failed (%d)\n", per_cu); per_cu = 1; }
        (void)hipGetLastError();
        grid = cus * per_cu;
        if (grid > 256) grid = 256;
    }
    if (grid < 0) return;
    hipMemsetAsync((char*)d_ws + WS_CTL, 0, CTL_BYTES, stream);
    Args a{};
    for (int i = 0; i < 25; ++i) a.in[i] = (const float*)d_in[i];
    a.out = (float*)d_out; a.ws = (unsigned char*)d_ws;
    void* kargs[] = {&a};
    hipError_t e = hipLaunchCooperativeKernel((const void*)hymba_fwd, dim3(grid), dim3(NTHREADS), kargs, LDS_BYTES, stream);
    if (e != hipSuccess) fprintf(stderr, "cooperative launch failed: %s (grid %d)\n", hipGetErrorString(e), grid);
}
```
